# Optimizing an MI355X kernel written in HIP

```python
import math
import jax, jax.numpy as jnp
from jax import lax
import numpy as np

D_MODEL = 1024
BATCH = 32
SEQ = 256
DEPTH = 4
DEC_BATCH = 8
DEC_SEQ = 4096
PAST_LEN = 256

GRID_W = 64
RET_HEADS = 4
RET_DK = 64
RET_DV = 64
RET_CHUNK = 128
DIFF_HEADS = 4
DIFF_DK = 32
DIFF_DV = 2 * DIFF_DK
MLA_HEADS = 8
MLA_NOPE = 64
MLA_ROPE = 32
MLA_DQK = MLA_NOPE + MLA_ROPE
MLA_DV = 64
MLA_Q_RANK = 768
MLA_KV_RANK = 256
RET_W = RET_HEADS * RET_DV
DIFF_W = DIFF_HEADS * DIFF_DV
MLA_W = MLA_HEADS * MLA_DV
MIX_W = RET_W + DIFF_W + MLA_W
IN_SPLIT_SIZES = (RET_HEADS * RET_DK, RET_HEADS * RET_DK, RET_W, RET_W,
                  DIFF_HEADS * 2 * DIFF_DK, DIFF_HEADS * 2 * DIFF_DK, DIFF_W,
                  MLA_Q_RANK, MLA_KV_RANK, MLA_ROPE)
D_IN = sum(IN_SPLIT_SIZES)
D_FF = -(-8 * D_MODEL // (3 * 256)) * 256
ROPE_BASE = 10000.0
QUERY_BLOCK = 128
EPS = 1e-6

kernel_name = "hybrid_retention_diffattn_mla_dit_step"

F32 = jnp.float32


def rms_norm(x, gain):
    x32 = x.astype(F32)
    y = x32 * lax.rsqrt(jnp.mean(x32 * x32, axis=-1, keepdims=True) + EPS)
    return (y * gain.astype(F32)).astype(x.dtype)


def head_group_norm(o, gain):
    mu = jnp.mean(o, axis=-1, keepdims=True)
    var = jnp.mean(jnp.square(o - mu), axis=-1, keepdims=True)
    return (o - mu) * lax.rsqrt(var + EPS) * gain.astype(F32).reshape(o.shape[-2], o.shape[-1])


def axial_rope_tables(n, rot_dim):
    rows = n // GRID_W
    row = jnp.repeat(jnp.arange(rows, dtype=F32), GRID_W)
    col = jnp.tile(jnp.arange(GRID_W, dtype=F32), rows)
    n_freq = rot_dim // 4
    inv = 1.0 / (ROPE_BASE ** (jnp.arange(n_freq, dtype=F32) / n_freq))
    ang = jnp.concatenate([row[:, None] * inv[None], col[:, None] * inv[None]], axis=-1)
    return jnp.cos(ang), jnp.sin(ang)


def apply_rope(x, cos, sin):
    shape = (x.shape[1],) + (1,) * (x.ndim - 3) + (cos.shape[-1],)
    c = cos.reshape(shape)
    s = sin.reshape(shape)
    x32 = x.astype(F32)
    x1, x2 = jnp.split(x32, 2, axis=-1)
    return jnp.concatenate([x1 * c - x2 * s, x2 * c + x1 * s], axis=-1).astype(x.dtype)


def sweep_query_blocks(fn, q):
    b, n = q.shape[0], q.shape[1]
    nb = n // QUERY_BLOCK
    qb = jnp.moveaxis(q.reshape((b, nb, QUERY_BLOCK) + q.shape[2:]), 1, 0)
    out = jnp.moveaxis(lax.map(fn, qb), 0, 1)
    return out.reshape((b, n) + out.shape[3:])


def softmax_attend(q, k, v):
    scale = q.shape[-1] ** -0.5
    k32 = k.astype(F32)
    v32 = v.astype(F32)

    def block(qb):
        s = jnp.einsum('bqhd,bkhd->bhqk', qb.astype(F32), k32) * scale
        p = jax.nn.softmax(s, axis=-1)
        return jnp.einsum('bhqk,bkhe->bqhe', p, v32)

    return sweep_query_blocks(block, q)


def diff_attend(q, k, v, lam):
    scale = q.shape[-1] ** -0.5
    k32 = k.astype(F32)
    v32 = v.astype(F32)

    def block(qb):
        s = jnp.einsum('bqhmd,bkhmd->bhmqk', qb.astype(F32), k32) * scale
        p = jax.nn.softmax(s, axis=-1)
        a = p[:, :, 0] - lam * p[:, :, 1]
        return jnp.einsum('bhqk,bkhe->bqhe', a, v32)

    return sweep_query_blocks(block, q)


def retention_scan(q, k, v, log_gamma, s0):
    b, n, nh, _ = q.shape
    dv = v.shape[-1]
    C = RET_CHUNK
    nc = n // C
    idx = jnp.arange(C, dtype=F32)
    dist = idx[:, None] - idx[None, :]
    causal = dist >= 0
    intra = jnp.where(causal[None], jnp.exp(log_gamma[:, None, None] * jnp.where(causal, dist, 0.0)[None]), 0.0)
    q_decay = jnp.exp(log_gamma[None, :] * (idx[:, None] + 1.0))
    k_decay = jnp.exp(log_gamma[None, :] * (C - 1.0 - idx[:, None]))
    chunk_decay = jnp.exp(log_gamma * C)

    def to_chunks(a):
        return jnp.moveaxis(a.reshape(b, nc, C, nh, a.shape[-1]), 1, 0)

    def step(s, blk):
        qc, kc, vc = blk
        att = jnp.einsum('bnhd,bmhd->bhnm', qc, kc) * intra[None]
        o = (jnp.einsum('bhnm,bmhe->bnhe', att, vc)
             + jnp.einsum('bnhd,bhde->bnhe', qc, s) * q_decay[None, :, :, None])
        s = (s * chunk_decay[None, :, None, None]
             + jnp.einsum('bmhd,bmhe->bhde', kc * k_decay[None, :, :, None], vc))
        return s, o

    s_final, o = lax.scan(step, s0, (to_chunks(q), to_chunks(k), to_chunks(v)))
    return jnp.moveaxis(o, 0, 1).reshape(b, n, nh, dv), s_final


def bi_retention(q, k, v, log_gamma, s0):
    o_f, s_f = retention_scan(q, k, v, log_gamma[0], s0[:, 0])
    o_b, s_b = retention_scan(q[:, ::-1], k[:, ::-1], v[:, ::-1], log_gamma[1], s0[:, 1])
    return o_f + o_b[:, ::-1], jnp.stack([s_f, s_b], axis=1)


def mla_keys_values(ckv_n, kr, w_ukv, k_gain):
    b, n, _ = ckv_n.shape
    kv = (ckv_n @ w_ukv).reshape(b, n, MLA_HEADS, MLA_NOPE + MLA_DV)
    k = jnp.concatenate([kv[..., :MLA_NOPE],
                         jnp.broadcast_to(kr[:, :, None, :], (b, n, MLA_HEADS, MLA_ROPE)).astype(kv.dtype)], axis=-1)
    return rms_norm(k, k_gain), kv[..., MLA_NOPE:]


def token_mixers(h, lp, lam_init, ctx):
    b, n, _ = h.shape
    offs = np.cumsum(IN_SPLIT_SIZES)[:-1].tolist()
    rq, rk, rv, rg, dq, dk, dv, cq, ckv, kr = jnp.split(h @ lp["w_in"], offs, axis=-1)
    rq = rq.reshape(b, n, RET_HEADS, RET_DK)
    rk = rk.reshape(b, n, RET_HEADS, RET_DK)
    rv = rv.reshape(b, n, RET_HEADS, RET_DV)
    dq = rms_norm(dq.reshape(b, n, DIFF_HEADS, 2, DIFF_DK), lp["diff_qk_gain"][0])
    dk = rms_norm(dk.reshape(b, n, DIFF_HEADS, 2, DIFF_DK), lp["diff_qk_gain"][1])
    dv = dv.reshape(b, n, DIFF_HEADS, DIFF_DV)
    mq = rms_norm((rms_norm(cq, lp["mla_q_norm"]) @ lp["w_uq"]).reshape(b, n, MLA_HEADS, MLA_DQK),
                  lp["mla_qk_gain"][0])
    ckv_n = rms_norm(ckv, lp["mla_kv_norm"])
    mk, mv = mla_keys_values(ckv_n, kr, lp["w_ukv"], lp["mla_qk_gain"][1])

    if ctx is None:
        state0 = jnp.zeros((b, 2, RET_HEADS, RET_DK, RET_DV), F32)
        dk_all, dv_all, mk_all, mv_all = dk, dv, mk, mv
    else:
        state0, ctx_dk, ctx_dv, ctx_ckv, ctx_kr = ctx
        cos_r, sin_r = axial_rope_tables(n, RET_DK)
        cos_s, sin_s = axial_rope_tables(n, DIFF_DK)
        rq = apply_rope(rq, cos_r, sin_r)
        rk = apply_rope(rk, cos_r, sin_r)
        dq = apply_rope(dq, cos_s, sin_s)
        dk = apply_rope(dk, cos_s, sin_s)
        mq = jnp.concatenate([mq[..., :MLA_NOPE], apply_rope(mq[..., MLA_NOPE:], cos_s, sin_s)], axis=-1)
        mk = jnp.concatenate([mk[..., :MLA_NOPE], apply_rope(mk[..., MLA_NOPE:], cos_s, sin_s)], axis=-1)
        ctx_mk, ctx_mv = mla_keys_values(ctx_ckv.astype(h.dtype), ctx_kr.astype(h.dtype), lp["w_ukv"], lp["mla_qk_gain"][1])
        dk_all = jnp.concatenate([dk, ctx_dk.astype(dk.dtype)], axis=1)
        dv_all = jnp.concatenate([dv, ctx_dv.astype(dv.dtype)], axis=1)
        mk_all = jnp.concatenate([mk, ctx_mk.astype(mk.dtype)], axis=1)
        mv_all = jnp.concatenate([mv, ctx_mv.astype(mv.dtype)], axis=1)

    log_gamma = jax.nn.log_sigmoid(lp["ret_decay"].astype(F32))
    o_ret, states = bi_retention(rq.astype(F32), rk.astype(F32) * (RET_DK ** -0.5), rv.astype(F32),
                                 log_gamma, state0.astype(F32))
    ret = head_group_norm(o_ret, lp["ret_gn_gain"]).reshape(b, n, RET_W) * jax.nn.silu(rg.astype(F32))

    dl = lp["diff_lambda"].astype(F32)
    lam = jnp.exp(jnp.sum(dl[0] * dl[1])) - jnp.exp(jnp.sum(dl[2] * dl[3])) + lam_init
    o_diff = diff_attend(dq, dk_all, dv_all, lam)
    diff = (rms_norm(o_diff, lp["diff_subln_gain"]) * (1.0 - lam_init)).reshape(b, n, DIFF_W)

    mla = softmax_attend(mq, mk_all, mv_all).reshape(b, n, MLA_W)

    mixed = jnp.concatenate([ret.astype(h.dtype), diff.astype(h.dtype), mla.astype(h.dtype)], axis=-1)
    ctx_out = (states, dk, dv, ckv_n, kr) if ctx is None else None
    return mixed, ctx_out


def trunk_layer(x, cond, lp, lam_init, ctx):
    mod = (jax.nn.silu(cond) @ lp["w_mod"] + lp["b_mod"])[:, None, :]
    shift1, scale1, gate1, shift2, scale2, gate2 = jnp.split(mod, 6, axis=-1)
    h = rms_norm(x, lp["norm1"]) * (1.0 + scale1) + shift1
    mixed, ctx_out = token_mixers(h, lp, lam_init, ctx)
    x = x + gate1 * (mixed @ lp["w_out"])
    h = rms_norm(x, lp["norm2"]) * (1.0 + scale2) + shift2
    g, u = jnp.split(h @ lp["w_gu"], 2, axis=-1)
    x = x + gate2 * ((jax.nn.silu(g) * u) @ lp["w_down"])
    return x, ctx_out


def setup_inputs(seed: int = 0) -> dict:
    key = jax.random.key(seed)
    ks = iter(jax.random.split(key, 40))

    def nrm(shape, scale):
        return jax.random.normal(next(ks), shape, F32) * scale

    def gain(shape):
        return 1.0 + nrm(shape, 0.02)

    gamma0 = 1.0 - 2.0 ** (-5.0 - jnp.arange(RET_HEADS, dtype=F32))
    decay_logit0 = jnp.log(gamma0) - jnp.log1p(-gamma0)
    return {
        "x_prompt": nrm((BATCH, SEQ, D_MODEL), 1.0),
        "x_sample": nrm((DEC_BATCH, DEC_SEQ, D_MODEL), 1.0),
        "c": nrm((DEC_BATCH, D_MODEL), 1.0),
        "state_ret": nrm((DEC_BATCH, DEPTH, 2, RET_HEADS, RET_DK, RET_DV), 1.0),
        "cache_diff_k": nrm((DEC_BATCH, DEPTH, PAST_LEN, DIFF_HEADS, 2, DIFF_DK), 1.0),
        "cache_diff_v": nrm((DEC_BATCH, DEPTH, PAST_LEN, DIFF_HEADS, DIFF_DV), 1.0),
        "cache_mla_ckv": nrm((DEC_BATCH, DEPTH, PAST_LEN, MLA_KV_RANK), 1.0),
        "cache_mla_kr": nrm((DEC_BATCH, DEPTH, PAST_LEN, MLA_ROPE), 1.0),
        "c_ctx": nrm((D_MODEL,), 1.0),
        "w_mod": nrm((DEPTH, D_MODEL, 6 * D_MODEL), 0.5 * D_MODEL ** -0.5),
        "b_mod": nrm((DEPTH, 6 * D_MODEL), 0.01),
        "norm1": gain((DEPTH, D_MODEL)),
        "norm2": gain((DEPTH, D_MODEL)),
        "w_in": nrm((DEPTH, D_MODEL, D_IN), D_MODEL ** -0.5),
        "ret_decay": decay_logit0[None, None, :] + nrm((DEPTH, 2, RET_HEADS), 0.1),
        "ret_gn_gain": gain((DEPTH, RET_W)),
        "diff_qk_gain": gain((DEPTH, 2, DIFF_DK)),
        "diff_lambda": nrm((DEPTH, 4, DIFF_DK), 0.1),
        "diff_subln_gain": gain((DEPTH, DIFF_DV)),
        "mla_q_norm": gain((DEPTH, MLA_Q_RANK)),
        "mla_kv_norm": gain((DEPTH, MLA_KV_RANK)),
        "w_uq": nrm((DEPTH, MLA_Q_RANK, MLA_HEADS * MLA_DQK), MLA_Q_RANK ** -0.5),
        "w_ukv": nrm((DEPTH, MLA_KV_RANK, MLA_HEADS * (MLA_NOPE + MLA_DV)), MLA_KV_RANK ** -0.5),
        "mla_qk_gain": gain((DEPTH, 2, MLA_DQK)),
        "w_out": nrm((DEPTH, MIX_W, D_MODEL), MIX_W ** -0.5),
        "w_gu": nrm((DEPTH, D_MODEL, 2 * D_FF), D_MODEL ** -0.5),
        "w_down": nrm((DEPTH, D_FF, D_MODEL), D_FF ** -0.5),
    }


def reference(x_prompt, x_sample, c, state_ret, cache_diff_k, cache_diff_v, cache_mla_ckv, cache_mla_kr,
              c_ctx, w_mod, b_mod, norm1, norm2, w_in, ret_decay, ret_gn_gain, diff_qk_gain, diff_lambda,
              diff_subln_gain, mla_q_norm, mla_kv_norm, w_uq, w_ukv, mla_qk_gain, w_out, w_gu, w_down):
    y_p = x_prompt
    y_s = x_sample
    new_ret, new_dk, new_dv, new_ckv, new_kr = [], [], [], [], []
    for l in range(DEPTH):
        lp = {
            "w_mod": w_mod[l], "b_mod": b_mod[l], "norm1": norm1[l], "norm2": norm2[l],
            "w_in": w_in[l], "ret_decay": ret_decay[l], "ret_gn_gain": ret_gn_gain[l],
            "diff_qk_gain": diff_qk_gain[l], "diff_lambda": diff_lambda[l],
            "diff_subln_gain": diff_subln_gain[l], "mla_q_norm": mla_q_norm[l],
            "mla_kv_norm": mla_kv_norm[l], "w_uq": w_uq[l], "w_ukv": w_ukv[l],
            "mla_qk_gain": mla_qk_gain[l], "w_out": w_out[l], "w_gu": w_gu[l], "w_down": w_down[l],
        }
        lam_init = 0.8 - 0.6 * math.exp(-0.3 * l)
        y_p, (s_l, dk_l, dv_l, ckv_l, kr_l) = trunk_layer(y_p, c_ctx[None, :], lp, lam_init, None)
        new_ret.append(s_l)
        new_dk.append(dk_l)
        new_dv.append(dv_l)
        new_ckv.append(ckv_l)
        new_kr.append(kr_l)
        cache_l = (state_ret[:, l], cache_diff_k[:, l], cache_diff_v[:, l], cache_mla_ckv[:, l], cache_mla_kr[:, l])
        y_s, _ = trunk_layer(y_s, c, lp, lam_init, cache_l)
    new_state_ret = jnp.stack(new_ret, axis=1)
    new_diff_k = jnp.stack(new_dk, axis=1)
    new_diff_v = jnp.stack(new_dv, axis=1)
    new_mla_ckv = jnp.stack(new_ckv, axis=1)
    new_mla_kr = jnp.stack(new_kr, axis=1)
    return (y_p, y_s, new_state_ret, new_diff_k, new_diff_v, new_mla_ckv, new_mla_kr)
```

```cpp
#include <hip/hip_runtime.h>
#include <hip/hip_cooperative_groups.h>
#include <cstdio>
namespace cg = cooperative_groups;

#ifndef MK_COOP
#define MK_COOP 1
#endif

#define LAS __attribute__((address_space(3)))
#define DI __device__ __forceinline__
typedef unsigned short bf16_t;
typedef short bf16x8 __attribute__((ext_vector_type(8)));
typedef short bf16x4 __attribute__((ext_vector_type(4)));
typedef float f32x4 __attribute__((ext_vector_type(4)));
typedef float f32x16 __attribute__((ext_vector_type(16)));
typedef unsigned u32x4 __attribute__((ext_vector_type(4)));
typedef unsigned u32x2 __attribute__((ext_vector_type(2)));
typedef __bf16 bf16v2 __attribute__((ext_vector_type(2)));

constexpr int D = 1024, NCTX = 8192, NLAT = 32768, NTOK = 40960, NKVROWS = 43008, NCACHE = 2048;
constexpr int LQKV = 1792, LCQ = 768, LCKV = 256, LKR = 32, LMQ = 768, LKV = 1280, DFF = 2816;
constexpr float EPS = 1e-6f;
constexpr float LOG2E = 1.4426950408889634f;

constexpr size_t O_YP = 0, O_YS = 8388608, O_STATE = 41943040, O_DK = 46137344, O_DV = 54525952, O_CKV = 62914560, O_KR = 71303168;

constexpr size_t OFF_MOD = 0, OFF_SCAL = 884736, OFF_CNT = 884736 + 1024, OFF_BAR = 884736 + 2048;
constexpr size_t OFF_ROPE64 = 1ull << 20, OFF_ROPE32 = 2ull << 20;
constexpr size_t OFF_WIN = 3145728, OFF_WUQ = 9437184, OFF_WUKV = 10616832, OFF_WOUT = 11141120, OFF_WGU = 13238272, OFF_WDOWN = 24772608;
constexpr size_t OFF_H = 31457280, OFF_QKV = 115343360, OFF_CQ = 262144000, OFF_CKV = 325058560, OFF_KR = 347078656;
constexpr size_t OFF_MQ = 349831168, OFF_KV = 412745728, OFF_DKC = 522846208, OFF_DVC = 523894784, WS_END = 524943360;
constexpr size_t OFF_ACT = OFF_QKV;
constexpr size_t OFF_SSQ = 2621440;
constexpr size_t OFF_U = OFF_H;
constexpr size_t OFF_MIX = OFF_CQ;

constexpr int LDS_CTL = 135168;
constexpr int LDS_BYTES = LDS_CTL + 64;

struct Params {
  const float *x_prompt, *x_sample, *c, *state_ret, *cache_dk, *cache_dv, *cache_ckv, *cache_kr, *c_ctx, *w_mod, *b_mod, *norm1, *norm2, *w_in,
      *ret_decay, *ret_gn, *diff_qk_gain, *diff_lambda, *diff_subln, *mla_q_norm, *mla_kv_norm, *w_uq, *w_ukv, *mla_qk_gain, *w_out, *w_gu, *w_down;
  float* out;
  unsigned char* ws;
  long long ph_lo, ph_hi;
};

DI int otid() { int t = threadIdx.x; asm volatile("" : "+v"(t)); return t; }
DI int ogsz() { int g = gridDim.x * 512; asm volatile("" : "+s"(g)); return g; }
DI unsigned pk2(float a, float b) { bf16v2 v; v.x = (__bf16)a; v.y = (__bf16)b; return __builtin_bit_cast(unsigned, v); }
DI float bflo(unsigned u) { return __uint_as_float(u << 16); }
DI float bfhi(unsigned u) { return __uint_as_float(u & 0xffff0000u); }
DI float bf2f(bf16_t b) { return __uint_as_float(((unsigned)b) << 16); }
DI float sx(float v, int m) { const int l = otid() & 63; return __int_as_float(__builtin_amdgcn_ds_bpermute((l ^ m) << 2, __float_as_int(v))); }
DI float wave_sum(float v) {
#pragma unroll
  for (int m = 32; m >= 1; m >>= 1) v += sx(v, m);
  return v;
}
DI float fast_exp2(float x) { return __builtin_amdgcn_exp2f(x); }
#define MFMA32(a, b, c) __builtin_amdgcn_mfma_f32_32x32x16_bf16((a), (b), (c), 0, 0, 0)
DI int crow(int i, int h) { return (i & 3) + 8 * (i >> 2) + 4 * h; }
DI bf16x4 tr_read(LAS unsigned char* p) { return __builtin_amdgcn_ds_read_tr16_b64_v4i16((LAS bf16x4*)p); }
DI bf16x8 cat8(bf16x4 a, bf16x4 b) { return __builtin_shufflevector(a, b, 0, 1, 2, 3, 4, 5, 6, 7); }

namespace pg8 {
constexpr int BM = 256, BK = 64, HALF = 128, HTB = HALF * BK * 2, STAGE_BYTES = 8 * HTB, NXCD = 8, WGM = 8;
DI int lds_byte(int r, int c) { const int st = (r >> 4) * 2 + (c >> 5), rr = r & 15, cc = c & 31, ob = rr * 64 + cc * 2; return st * 1024 + (ob ^ (((ob >> 9) & 1) << 5)); }
DI void stage_rc(int b, int& R, int& C) { const int st = b / 1024, sb = b % 1024, swz = sb ^ (((sb >> 9) & 1) << 5); R = (st >> 1) * 16 + swz / 64; C = (st & 1) * 32 + (swz % 64) / 2; }
DI int perm32(int rho) { const int n = rho >> 4, i = rho & 15; return 8 * (i >> 2) + 4 * n + (i & 3); }
struct Unit { int pm, pn; };
struct Gemm { const bf16_t* A; const bf16_t* Bt; int M, N, K, lda; };
struct StaticOrder {
  int nM, nN, nwg, G, c;
  DI void init(int M, int N, int G_, int c_) { nM = M / BM; nN = N / BM; nwg = nM * nN; G = G_; c = c_; }
  DI bool next(int i, Unit& u) const {
    const long L = (long)i * G + c; if (L >= nwg) return false;
    int wgid = (int)L; { const int q = nwg / NXCD, r = nwg % NXCD, xcd = wgid % NXCD, off = wgid / NXCD; wgid = (xcd < r ? xcd * (q + 1) : r * (q + 1) + (xcd - r) * q) + off; }
    const int nig = WGM * nN, gid = wgid / nig, fm = gid * WGM, gsz = (nM - fm) < WGM ? (nM - fm) : WGM;
    u.pm = fm + ((wgid % nig) % gsz); u.pn = (wgid % nig) / gsz; return true;
  }
};

template <class Epi>
DI void gemm_phase(LAS unsigned char* lds, const Gemm g, const StaticOrder& S, const Epi& E) {
  const int tid_ = otid();
  const int tid = tid_, wid = __builtin_amdgcn_readfirstlane(tid >> 6), lane = tid & 63, wr = wid >> 2, wc = wid & 3, fr = lane & 15, fq = lane >> 4;
  const int K = g.K, nt = K / BK, lda = g.lda;
  unsigned voffA[2], voffB[2];
#pragma unroll
  for (int i = 0; i < 2; ++i) { int R, C; stage_rc(tid * 16 + i * 8192, R, C); const int Rb = Epi::PERM ? ((R & ~31) + perm32(R & 31)) : R;
    voffA[i] = (unsigned)(R * lda + C) * 2u; voffB[i] = (unsigned)(Rb * K + C) * 2u; }
  const size_t kstep = (size_t)(BK * 2);
  const size_t hstepA = (size_t)HALF * lda * 2, hstepB = (size_t)HALF * K * 2;
  const size_t tstepA = 2 * hstepA, tstepB = 2 * hstepB;
  const unsigned ldsw = (unsigned)wid * 1024u;
  const int aoff = lds_byte(wr * 64 + fr, fq * 8), boff = lds_byte(wc * 32 + fr, fq * 8);
#define PG8_SA(b, h) (((b) * 2 + (h)) * HTB)
#define PG8_SB(b, h) ((4 + (b) * 2 + (h)) * HTB)
#define PG8_STAGE(bufoff, gbase, voff) do { _Pragma("unroll") for (int _i = 0; _i < 2; ++_i) \
        __builtin_amdgcn_global_load_lds((const unsigned*)((const char*)(gbase) + (voff)[_i]), (LAS unsigned*)(lds + (bufoff) + ldsw + _i * 8192), 16, 0, 0); } while (0)
#define PG8_LDA(dst, b, h) do { _Pragma("unroll") for (int m = 0; m < 4; ++m) _Pragma("unroll") for (int k = 0; k < 2; ++k) dst[m][k] = *(const LAS bf16x8*)(lds + PG8_SA(b, h) + aoff + m * 2048 + k * 1024); } while (0)
#define PG8_LDB(dst, b, h) do { _Pragma("unroll") for (int n = 0; n < 2; ++n) _Pragma("unroll") for (int k = 0; k < 2; ++k) dst[n][k] = *(const LAS bf16x8*)(lds + PG8_SB(b, h) + boff + n * 2048 + k * 1024); } while (0)
#define PG8_MMA(ai, bj, At, Bt) do { __builtin_amdgcn_s_setprio(1); _Pragma("unroll") for (int m = 0; m < 4; ++m) _Pragma("unroll") for (int n = 0; n < 2; ++n) _Pragma("unroll") for (int k = 0; k < 2; ++k) \
        acc[ai][bj][m][n] = __builtin_amdgcn_mfma_f32_16x16x32_bf16(Bt[n][k], At[m][k], acc[ai][bj][m][n], 0, 0, 0); __builtin_amdgcn_s_setprio(0); } while (0)
#define PG8_WAIT_V(n) asm volatile("s_waitcnt vmcnt(" #n ")" ::: "memory")
#define PG8_WAIT_L(n) asm volatile("s_waitcnt lgkmcnt(" #n ")" ::: "memory")
#define PG8_BAR __builtin_amdgcn_s_barrier()
#define PG8_SCHED __builtin_amdgcn_sched_barrier(0)
  Unit cur, nxt; int ui = 0;
  if (!S.next(0, cur)) return;
  f32x4 acc[2][2][4][2];
#pragma unroll
  for (int a = 0; a < 2; ++a)
#pragma unroll
    for (int b = 0; b < 2; ++b)
#pragma unroll
      for (int m = 0; m < 4; ++m)
#pragma unroll
        for (int n = 0; n < 2; ++n) acc[a][b][m][n] = (f32x4){0.f, 0.f, 0.f, 0.f};
  bf16x8 At[4][2], B0[2][2], B1[2][2];
  const char* cA = (const char*)g.A + (size_t)cur.pm * tstepA; const char* cB = (const char*)g.Bt + (size_t)cur.pn * tstepB;
  PG8_STAGE(PG8_SB(0, 0), cB, voffB); PG8_STAGE(PG8_SA(0, 0), cA, voffA); PG8_STAGE(PG8_SB(0, 1), cB + hstepB, voffB); PG8_STAGE(PG8_SA(0, 1), cA + hstepA, voffA);
  if (wr == 1) PG8_BAR;
  PG8_WAIT_V(4); PG8_BAR;
  PG8_STAGE(PG8_SB(1, 0), cB + kstep, voffB); PG8_STAGE(PG8_SA(1, 0), cA + kstep, voffA); PG8_STAGE(PG8_SB(1, 1), cB + hstepB + kstep, voffB);
  PG8_WAIT_V(6); PG8_BAR;
  for (;;) {
    const bool has_next = S.next(ui + 1, nxt);
    const char* nA = has_next ? (const char*)g.A + (size_t)nxt.pm * tstepA : cA; const char* nB = has_next ? (const char*)g.Bt + (size_t)nxt.pn * tstepB : cB;
    for (int t = 0; t < nt; t += 2) {
      const bool last = (t == nt - 2);
      const char* a1 = cA + (size_t)(t + 1) * kstep;
      const char* a2 = last ? nA : cA + (size_t)(t + 2) * kstep; const char* b2 = last ? nB : cB + (size_t)(t + 2) * kstep;
      const char* a3 = a2 + kstep; const char* b3 = b2 + kstep;
      PG8_LDB(B0, 0, 0); PG8_SCHED; PG8_LDA(At, 0, 0); PG8_STAGE(PG8_SA(1, 1), a1 + hstepA, voffA);
      PG8_WAIT_L(8); PG8_BAR; PG8_WAIT_L(0); PG8_MMA(0, 0, At, B0); PG8_BAR; PG8_SCHED;
      PG8_LDB(B1, 0, 1); PG8_STAGE(PG8_SB(0, 0), b2, voffB);
      PG8_BAR; PG8_WAIT_L(0); PG8_MMA(0, 1, At, B1); PG8_BAR;
      PG8_LDA(At, 0, 1); PG8_STAGE(PG8_SA(0, 0), a2, voffA);
      PG8_BAR; PG8_WAIT_L(0); PG8_MMA(1, 0, At, B0); PG8_BAR; PG8_SCHED;
      PG8_STAGE(PG8_SB(0, 1), b2 + hstepB, voffB);
      PG8_WAIT_V(6); PG8_BAR; PG8_MMA(1, 1, At, B1); PG8_BAR;
      PG8_LDB(B0, 1, 0); PG8_SCHED; PG8_LDA(At, 1, 0); PG8_STAGE(PG8_SA(0, 1), a2 + hstepA, voffA);
      PG8_WAIT_L(8); PG8_BAR; PG8_WAIT_L(0); PG8_MMA(0, 0, At, B0); PG8_BAR; PG8_SCHED;
      PG8_LDB(B1, 1, 1); PG8_STAGE(PG8_SB(1, 0), b3, voffB);
      PG8_BAR; PG8_WAIT_L(0); PG8_MMA(0, 1, At, B1); PG8_BAR;
      PG8_LDA(At, 1, 1); PG8_STAGE(PG8_SA(1, 0), a3, voffA);
      PG8_BAR; PG8_WAIT_L(0); PG8_MMA(1, 0, At, B0); PG8_BAR; PG8_SCHED;
      PG8_STAGE(PG8_SB(1, 1), b3 + hstepB, voffB);
      PG8_WAIT_V(6); PG8_BAR; PG8_MMA(1, 1, At, B1); PG8_BAR;
    }
    E(acc, cur, wr, wc, fr, fq);
    if (!has_next) break;
#pragma unroll
    for (int a = 0; a < 2; ++a)
#pragma unroll
      for (int b = 0; b < 2; ++b)
#pragma unroll
        for (int m = 0; m < 4; ++m)
#pragma unroll
          for (int n = 0; n < 2; ++n) acc[a][b][m][n] = (f32x4){0.f, 0.f, 0.f, 0.f};
    cur = nxt; cA = nA; cB = nB; ++ui;
  }
  PG8_WAIT_V(0);
  if (wr == 0) PG8_BAR;
  PG8_BAR;
#undef PG8_SA
#undef PG8_SB
#undef PG8_STAGE
#undef PG8_LDA
#undef PG8_LDB
#undef PG8_MMA
#undef PG8_WAIT_V
#undef PG8_WAIT_L
#undef PG8_BAR
#undef PG8_SCHED
}
}
using pg8::Unit;

struct EpiIn {
  static constexpr bool PERM = true;
  bf16_t *qkv, *cq, *ckv, *kr; float* ssq;
  DI void operator()(const f32x4 (&acc)[2][2][4][2], const Unit& u, int wr, int wc, int fr, int fq) const {
    const int row0 = u.pm * 256 + wr * 64 + fr; const int colt = u.pn * 256 + wc * 32 + 8 * fq;
    bf16_t* base; int ld, c0; bool okhi = true;
    if (u.pn < 7) { base = qkv; ld = LQKV; c0 = colt; }
    else if (u.pn < 10) { base = cq; ld = LCQ; c0 = colt - 1792; }
    else if (u.pn == 10) { base = ckv; ld = LCKV; c0 = colt - 2560; }
    else { base = kr; ld = LKR; c0 = colt - 2816; okhi = false; }
    const bool iscq = u.pn >= 7 && u.pn < 10;
#pragma unroll
    for (int ai = 0; ai < 2; ++ai)
#pragma unroll
      for (int m = 0; m < 4; ++m) { bf16_t* rowp = base + (size_t)(row0 + ai * 128 + m * 16) * ld + c0;
        float sq = 0.f;
#pragma unroll
        for (int bj = 0; bj < 2; ++bj) { const f32x4 v0 = acc[ai][bj][m][0], v1 = acc[ai][bj][m][1];
          if (iscq) sq += v0[0] * v0[0] + v0[1] * v0[1] + v0[2] * v0[2] + v0[3] * v0[3] + v1[0] * v1[0] + v1[1] * v1[1] + v1[2] * v1[2] + v1[3] * v1[3];
          u32x4 w; w.x = pk2(v0[0], v0[1]); w.y = pk2(v0[2], v0[3]); w.z = pk2(v1[0], v1[1]); w.w = pk2(v1[2], v1[3]);
          if (okhi || (bj == 0 && c0 < 32)) *(u32x4*)(rowp + bj * 128) = w; }
        if (iscq) { sq += sx(sq, 16); sq += sx(sq, 32); if (fq == 0) unsafeAtomicAdd(ssq + row0 + ai * 128 + m * 16, sq); } }
  }
};
struct EpiPlain {
  static constexpr bool PERM = true;
  bf16_t* O; int ld;
  DI void operator()(const f32x4 (&acc)[2][2][4][2], const Unit& u, int wr, int wc, int fr, int fq) const {
    const int row0 = u.pm * 256 + wr * 64 + fr; const int c0 = u.pn * 256 + wc * 32 + 8 * fq;
#pragma unroll
    for (int ai = 0; ai < 2; ++ai)
#pragma unroll
      for (int m = 0; m < 4; ++m) { bf16_t* rowp = O + (size_t)(row0 + ai * 128 + m * 16) * ld + c0;
#pragma unroll
        for (int bj = 0; bj < 2; ++bj) { const f32x4 v0 = acc[ai][bj][m][0], v1 = acc[ai][bj][m][1];
          u32x4 w; w.x = pk2(v0[0], v0[1]); w.y = pk2(v0[2], v0[3]); w.z = pk2(v1[0], v1[1]); w.w = pk2(v1[2], v1[3]);
          *(u32x4*)(rowp + bj * 128) = w; } }
  }
};
struct EpiKV {
  static constexpr bool PERM = true;
  bf16_t* O;
  DI void operator()(const f32x4 (&acc)[2][2][4][2], const Unit& u, int wr, int wc, int fr, int fq) const {
    const int row0 = u.pm * 256 + wr * 64 + fr;
#pragma unroll
    for (int ai = 0; ai < 2; ++ai)
#pragma unroll
      for (int m = 0; m < 4; ++m) { bf16_t* rowp = O + (size_t)(row0 + ai * 128 + m * 16) * LKV;
#pragma unroll
        for (int bj = 0; bj < 2; ++bj) { const f32x4 v0 = acc[ai][bj][m][0], v1 = acc[ai][bj][m][1];
          const int head = u.pn * 2 + bj, w128 = wc * 32 + 8 * fq; const int dst = head * 160 + (w128 < 64 ? w128 : w128 + 32);
          u32x4 w; w.x = pk2(v0[0], v0[1]); w.y = pk2(v0[2], v0[3]); w.z = pk2(v1[0], v1[1]); w.w = pk2(v1[2], v1[3]);
          *(u32x4*)(rowp + dst) = w; } }
  }
};
struct EpiRes {
  static constexpr bool PERM = false;
  float* X; const float* modl; int goff;
  const float* Xp; const float* Xs;
  DI void operator()(const f32x4 (&acc)[2][2][4][2], const Unit& u, int wr, int wc, int fr, int fq) const {
    const int rowt = u.pm * 256; const int mrow = rowt < NCTX ? 8 : ((rowt - NCTX) >> 12);
    const int row0 = rowt + wr * 64 + fr, col0 = u.pn * 256 + wc * 32 + 4 * fq;
    const float* gp = modl + mrow * 6144 + goff + col0;
    f32x4 gv[2][2];
#pragma unroll
    for (int bj = 0; bj < 2; ++bj)
#pragma unroll
      for (int n = 0; n < 2; ++n) gv[bj][n] = *(const f32x4*)(gp + bj * 128 + n * 16);
    const float* xin = Xp ? (rowt < NCTX ? Xp : Xs - (size_t)NCTX * D) : X;
    f32x4 xa[2][2][2], xb[2][2][2];
    auto qload = [&](int q, f32x4 (&xv)[2][2][2]) {
#pragma unroll
      for (int mm = 0; mm < 2; ++mm) { const float* rowp = xin + (size_t)(row0 + (q >> 1) * 128 + ((q & 1) * 2 + mm) * 16) * D + col0;
#pragma unroll
        for (int bj = 0; bj < 2; ++bj)
#pragma unroll
          for (int n = 0; n < 2; ++n) xv[mm][bj][n] = *(const f32x4*)(rowp + bj * 128 + n * 16); } };
    auto qstore = [&](int q, const f32x4 (&xv)[2][2][2]) {
#pragma unroll
      for (int mm = 0; mm < 2; ++mm) { float* rowp = X + (size_t)(row0 + (q >> 1) * 128 + ((q & 1) * 2 + mm) * 16) * D + col0;
#pragma unroll
        for (int bj = 0; bj < 2; ++bj)
#pragma unroll
          for (int n = 0; n < 2; ++n) *(f32x4*)(rowp + bj * 128 + n * 16) = xv[mm][bj][n] + gv[bj][n] * acc[q >> 1][bj][(q & 1) * 2 + mm][n]; } };
    qload(0, xa); qload(1, xb);
    qstore(0, xa); qload(2, xa);
    qstore(1, xb); qload(3, xb);
    qstore(2, xa); qstore(3, xb);
  }
};
struct EpiGU {
  static constexpr bool PERM = true;
  bf16_t* act;
  DI void operator()(const f32x4 (&acc)[2][2][4][2], const Unit& u, int wr, int wc, int fr, int fq) const {
    const int row0 = u.pm * 256 + wr * 64 + fr; const int ch0 = u.pn * 128 + wc * 32 + 8 * fq;
#pragma unroll
    for (int ai = 0; ai < 2; ++ai)
#pragma unroll
      for (int m = 0; m < 4; ++m) { bf16_t* rowp = act + (size_t)(row0 + ai * 128 + m * 16) * DFF + ch0; float r[8];
#pragma unroll
        for (int n = 0; n < 2; ++n) { const f32x4 g = acc[ai][0][m][n], uu = acc[ai][1][m][n];
#pragma unroll
          for (int j = 0; j < 4; ++j) { const float s = g[j] * __builtin_amdgcn_rcpf(1.0f + __expf(-g[j])); r[4 * n + j] = s * uu[j]; } }
        u32x4 w; w.x = pk2(r[0], r[1]); w.y = pk2(r[2], r[3]); w.z = pk2(r[4], r[5]); w.w = pk2(r[6], r[7]); *(u32x4*)rowp = w; }
  }
};

DI void phase0(const Params& p, LAS unsigned char* lds) {
  const int tid = otid(); const int gtid = blockIdx.x * 512 + tid, gsz = ogsz();
  float2* r64 = (float2*)(p.ws + OFF_ROPE64); float2* r32 = (float2*)(p.ws + OFF_ROPE32);
  for (int i = gtid; i < 4096 * 32; i += gsz) { const int t = i >> 5, j = i & 31; const float pos = (j < 16) ? (float)(t >> 6) : (float)(t & 63);
    const float inv = 1.0f / powf(10000.0f, (float)(j & 15) / 16.0f); const float a = pos * inv; r64[i] = make_float2(cosf(a), sinf(a)); }
  for (int i = gtid; i < 4096 * 16; i += gsz) { const int t = i >> 4, j = i & 15; const float pos = (j < 8) ? (float)(t >> 6) : (float)(t & 63);
    const float inv = 1.0f / powf(10000.0f, (float)(j & 7) / 8.0f); const float a = pos * inv; r32[i] = make_float2(cosf(a), sinf(a)); }
  if (blockIdx.x == 0 && tid < 4) {
    const int l = tid; float* sc = (float*)(p.ws + OFF_SCAL) + l * 16;
    const float lam_init = 0.8f - 0.6f * expf(-0.3f * (float)l);
    const float* dl = p.diff_lambda + l * 128; float s1 = 0.f, s2 = 0.f;
    for (int i = 0; i < 32; ++i) { s1 += dl[i] * dl[32 + i]; s2 += dl[64 + i] * dl[96 + i]; }
    sc[0] = expf(s1) - expf(s2) + lam_init; sc[1] = lam_init;
    float mq = 0.f, mk = 0.f; for (int i = 0; i < 32; ++i) { mq = fmaxf(mq, fabsf(p.diff_qk_gain[l * 64 + i])); mk = fmaxf(mk, fabsf(p.diff_qk_gain[l * 64 + 32 + i])); }
    sc[2] = sqrtf(32.0f) * mq * mk * LOG2E;
    mq = 0.f; mk = 0.f; for (int i = 0; i < 96; ++i) { mq = fmaxf(mq, fabsf(p.mla_qk_gain[l * 192 + i])); mk = fmaxf(mk, fabsf(p.mla_qk_gain[l * 192 + 96 + i])); }
    sc[3] = sqrtf(96.0f) * mq * mk * LOG2E;
    for (int h = 0; h < 4; ++h) { const float xf = p.ret_decay[l * 8 + h], xb = p.ret_decay[l * 8 + 4 + h];
      sc[4 + h] = -log1pf(expf(-xf)) * LOG2E; sc[8 + h] = -log1pf(expf(-xb)) * LOG2E; }
  }
  LAS float* sl = (LAS float*)lds; LAS float* red = (LAS float*)(lds + 36864);
  for (int i = tid; i < 9 * 1024; i += 512) { const int r = i >> 10, k = i & 1023; const float v = (r < 8) ? p.c[r * 1024 + k] : p.c_ctx[k]; sl[i] = v / (1.0f + __expf(-v)); }
  __syncthreads();
  const int kg = tid >> 5, cl = tid & 31;
  for (int slab = blockIdx.x; slab < 256; slab += gridDim.x) {
    const int l = slab >> 6, c0 = (slab & 63) * 96;
    const float* W = p.w_mod + (size_t)l * 1024 * 6144 + c0 + cl;
    float acc[9][3];
#pragma unroll
    for (int r = 0; r < 9; ++r) { acc[r][0] = 0.f; acc[r][1] = 0.f; acc[r][2] = 0.f; }
#pragma unroll 8
    for (int k = kg; k < 1024; k += 16) {
      const float w0 = W[(size_t)k * 6144], w1 = W[(size_t)k * 6144 + 32], w2 = W[(size_t)k * 6144 + 64];
#pragma unroll
      for (int r = 0; r < 9; ++r) { const float s = sl[r * 1024 + k]; acc[r][0] += s * w0; acc[r][1] += s * w1; acc[r][2] += s * w2; }
    }
#pragma unroll
    for (int r = 0; r < 9; ++r) { red[(kg * 9 + r) * 96 + cl] = acc[r][0]; red[(kg * 9 + r) * 96 + 32 + cl] = acc[r][1]; red[(kg * 9 + r) * 96 + 64 + cl] = acc[r][2]; }
    __syncthreads();
    for (int o = tid; o < 864; o += 512) { const int r = o / 96, cc = o % 96; float s = p.b_mod[l * 6144 + c0 + cc];
      for (int g = 0; g < 16; ++g) s += red[(g * 9 + r) * 96 + cc];
      ((float*)(p.ws + OFF_MOD))[(size_t)(l * 9 + r) * 6144 + c0 + cc] = s; }
    __syncthreads();
  }
}

DI void convert_weight_tile(const float* src, int K, int N, int nT, int tl, bf16_t* dst, int mode, LAS float* tile, const float* kgain = nullptr) {
  const int tid = otid(); const int nt = tl % nT, kt = tl / nT;
#pragma unroll
  for (int pass = 0; pass < 2; ++pass) { const int rr = pass * 32 + (tid >> 4), c4 = (tid & 15) * 4, n = nt * 64 + c4;
    f32x4 v = (f32x4){0.f, 0.f, 0.f, 0.f}; if (n < N) v = *(const f32x4*)(src + (size_t)(kt * 64 + rr) * N + n);
    tile[rr * 65 + c4] = v[0]; tile[rr * 65 + c4 + 1] = v[1]; tile[rr * 65 + c4 + 2] = v[2]; tile[rr * 65 + c4 + 3] = v[3]; }
  __syncthreads();
  { const int nn = tid >> 3, kk = (tid & 7) * 8; float v[8];
#pragma unroll
    for (int e = 0; e < 8; ++e) v[e] = tile[(kk + e) * 65 + nn];
    if (kgain) { const f32x4 g0 = *(const f32x4*)(kgain + kt * 64 + kk), g1 = *(const f32x4*)(kgain + kt * 64 + kk + 4);
#pragma unroll
      for (int e = 0; e < 4; ++e) { v[e] *= g0[e]; v[4 + e] *= g1[e]; } }
    const int n = nt * 64 + nn; int drow = n;
    if (mode == 1) { if (n < DFF) drow = 256 * (n >> 7) + (n & 127); else { const int c = n - DFF; drow = 256 * (c >> 7) + 128 + (c & 127); } }
    u32x4 w; w.x = pk2(v[0], v[1]); w.y = pk2(v[2], v[3]); w.z = pk2(v[4], v[5]); w.w = pk2(v[6], v[7]);
    *(u32x4*)(dst + (size_t)drow * K + kt * 64 + kk) = w; }
  __syncthreads();
}

DI void phase_norm(const Params& p, int l, int which, LAS unsigned char* lds) {
  const int tid = otid(), lane = tid & 63, wid = tid >> 6;
  const float* modl = (const float*)(p.ws + OFF_MOD) + (size_t)l * 9 * 6144;
  const float* gain = (which ? p.norm2 : p.norm1) + l * 1024;
  bf16_t* H = (bf16_t*)(p.ws + OFF_H);
  const bool first = (l == 0 && which == 0);
  int rstride = gridDim.x * 8; asm volatile("" : "+s"(rstride));
  f32x4 gn[4];
#pragma unroll
  for (int j = 0; j < 4; ++j) gn[j] = *(const f32x4*)(gain + j * 256 + lane * 4);
  for (int r0 = blockIdx.x * 8 + wid; r0 < NTOK; r0 += 2 * rstride) {
    f32x4 x[2][4], s1v[2][4], s0v[2][4]; const bool two = r0 + rstride < NTOK;
#pragma unroll
    for (int k = 0; k < 2; ++k) { const int r = r0 + k * rstride; if (k == 0 || two) {
      const float* src = first ? (r < NCTX ? p.x_prompt + (size_t)r * D : p.x_sample + (size_t)(r - NCTX) * D) : p.out + (size_t)r * D;
      const int mrow = r < NCTX ? 8 : ((r - NCTX) >> 12);
      const float* sh = modl + mrow * 6144 + (which ? 3072 : 0); const float* scl = sh + 1024;
#pragma unroll
      for (int j = 0; j < 4; ++j) { x[k][j] = *(const f32x4*)(src + j * 256 + lane * 4); s1v[k][j] = *(const f32x4*)(scl + j * 256 + lane * 4); s0v[k][j] = *(const f32x4*)(sh + j * 256 + lane * 4); } } }
#pragma unroll
    for (int k = 0; k < 2; ++k) { const int r = r0 + k * rstride; if (k == 0 || two) {
      float ss = 0.f;
#pragma unroll
      for (int j = 0; j < 4; ++j) ss += x[k][j][0] * x[k][j][0] + x[k][j][1] * x[k][j][1] + x[k][j][2] * x[k][j][2] + x[k][j][3] * x[k][j][3];
      ss = wave_sum(ss); const float rstd = rsqrtf(ss * (1.0f / 1024.0f) + EPS);
#pragma unroll
      for (int j = 0; j < 4; ++j) { const int c = j * 256 + lane * 4;
        f32x4 y = x[k][j] * rstd * gn[j]; y = y * (s1v[k][j] + 1.0f) + s0v[k][j];
        u32x2 w; w.x = pk2(y[0], y[1]); w.y = pk2(y[2], y[3]); *(u32x2*)(H + (size_t)r * D + c) = w;
        } } }
  }
  if (which) return;
  LAS float* tile = (LAS float*)lds;
  for (int t = blockIdx.x; t < 3344; t += gridDim.x) {
    if (t < 768) convert_weight_tile(p.w_in + (size_t)l * 1024 * 2848, 1024, 2848, 48, t, (bf16_t*)(p.ws + OFF_WIN), 0, tile);
    else if (t < 912) convert_weight_tile(p.w_uq + (size_t)l * 768 * 768, 768, 768, 12, t - 768, (bf16_t*)(p.ws + OFF_WUQ), 0, tile, p.mla_q_norm + l * 768);
    else if (t < 976) convert_weight_tile(p.w_ukv + (size_t)l * 256 * 1024, 256, 1024, 16, t - 912, (bf16_t*)(p.ws + OFF_WUKV), 0, tile);
    else if (t < 1232) convert_weight_tile(p.w_out + (size_t)l * 1024 * 1024, 1024, 1024, 16, t - 976, (bf16_t*)(p.ws + OFF_WOUT), 0, tile);
    else if (t < 2640) convert_weight_tile(p.w_gu + (size_t)l * 1024 * 5632, 1024, 5632, 88, t - 1232, (bf16_t*)(p.ws + OFF_WGU), 1, tile);
    else convert_weight_tile(p.w_down + (size_t)l * 2816 * 1024, 2816, 1024, 16, t - 2640, (bf16_t*)(p.ws + OFF_WDOWN), 0, tile);
  }
  { float* z = (float*)(p.ws + OFF_SSQ); const int zs = ogsz(); float zf = 0.f; asm volatile("" : "+v"(zf));
#pragma clang loop vectorize(disable)
    for (int i = blockIdx.x * 512 + tid; i < NTOK; i += zs) z[i] = zf; }
  const int gtid = blockIdx.x * 512 + tid, gsz = ogsz();
  bf16_t* CKV = (bf16_t*)(p.ws + OFF_CKV); bf16_t* KR = (bf16_t*)(p.ws + OFF_KR); bf16_t* DKC = (bf16_t*)(p.ws + OFF_DKC); bf16_t* DVC = (bf16_t*)(p.ws + OFF_DVC);
  for (int i = gtid; i < NCACHE * 256; i += gsz) { const int row = i >> 8, col = i & 255, b = row >> 8, t = row & 255; const size_t s = ((size_t)(b * 4 + l) * 256 + t) * 256 + col;
    CKV[(size_t)(NTOK + row) * 256 + col] = (bf16_t)(pk2(p.cache_ckv[s], 0.f) & 0xffff);
    DKC[i] = (bf16_t)(pk2(p.cache_dk[s], 0.f) & 0xffff); DVC[i] = (bf16_t)(pk2(p.cache_dv[s], 0.f) & 0xffff); }
  for (int i = gtid; i < NCACHE * 32; i += gsz) { const int row = i >> 5, col = i & 31, b = row >> 8, t = row & 255;
    KR[(size_t)(NTOK + row) * 32 + col] = (bf16_t)(pk2(p.cache_kr[((size_t)(b * 4 + l) * 256 + t) * 32 + col], 0.f) & 0xffff); }
}

DI void phase_post1(const Params& p, int l) {
  const int tid = otid(), lane = tid & 63, wid = tid >> 6;
  bf16_t* QKV = (bf16_t*)(p.ws + OFF_QKV); bf16_t* CQ = (bf16_t*)(p.ws + OFF_CQ); bf16_t* CKV = (bf16_t*)(p.ws + OFF_CKV); const bf16_t* KR = (const bf16_t*)(p.ws + OFF_KR);
  const float2* r64 = (const float2*)(p.ws + OFF_ROPE64); const float2* r32 = (const float2*)(p.ws + OFF_ROPE32);
  const float qscale_d = 0.17677669529663687f * LOG2E;
  struct Raw { u32x2 ra, rb, da, db, dv, cq[3], ck; float kr; f32x4 t64[2], t32[2]; };
  f32x4 gd1, gd2, gqn[3], gkv;
  { const float* g = p.diff_qk_gain + l * 64 + ((lane >> 2) >= 8 ? 32 : 0); gd1 = *(const f32x4*)(g + 4 * (lane & 3)); gd2 = *(const f32x4*)(g + 16 + 4 * (lane & 3));
#pragma unroll
    for (int j = 0; j < 3; ++j) gqn[j] = *(const f32x4*)(p.mla_q_norm + l * 768 + j * 256 + lane * 4);
    gkv = *(const f32x4*)(p.mla_kv_norm + l * 256 + lane * 4); }
  auto load_row = [&](int r, Raw& w) {
    const bf16_t* q = QKV + (size_t)r * LQKV;
    if ((lane >> 3) >= 4) { const bf16_t* base = q + (lane >> 3) * 64 + 4 * (lane & 7); w.ra = *(const u32x2*)base; w.rb = *(const u32x2*)(base + 32); }
    if ((lane >> 2) >= 8) { const bf16_t* base = q + 1024 + (lane >> 2) * 32 + 4 * (lane & 3); w.da = *(const u32x2*)base; w.db = *(const u32x2*)(base + 16); }
    if (r < NCTX) w.dv = *(const u32x2*)(q + 1536 + lane * 4);
    w.ck = *(const u32x2*)(CKV + (size_t)r * LCKV + lane * 4);
    w.kr = bf2f(KR[(size_t)r * LKR + (lane & 31)]);
    if (r >= NCTX) { const int t = (r - NCTX) & 4095; const f32x4* a = (const f32x4*)(r64 + t * 32 + 4 * (lane & 7)); w.t64[0] = a[0]; w.t64[1] = a[1];
      const f32x4* bq = (const f32x4*)(r32 + t * 16 + 4 * (lane & 3)); w.t32[0] = bq[0]; w.t32[1] = bq[1]; }
  };
  auto finish_row = [&](int r, const Raw& w) {
    const bool lat = r >= NCTX; const int t = lat ? ((r - NCTX) & 4095) : (r & 255); const int b = r >> 8;
    const size_t obase = ((size_t)(b * 4 + l) * 256 + t);
    bf16_t* q = QKV + (size_t)r * LQKV;
    if ((lane >> 3) >= 4) {
      const int hh = lane >> 3, sub = lane & 7; bf16_t* base = q + hh * 64 + 4 * sub;
      const u32x2 a = w.ra, bb = w.rb;
      float x1[4] = {bflo(a.x), bfhi(a.x), bflo(a.y), bfhi(a.y)}, x2[4] = {bflo(bb.x), bfhi(bb.x), bflo(bb.y), bfhi(bb.y)};
      const float sc = hh >= 4 ? 0.125f : 1.0f;
      if (lat) {
#pragma unroll
        for (int e = 0; e < 4; ++e) { const float cx = w.t64[e >> 1][2 * (e & 1)], cy = w.t64[e >> 1][2 * (e & 1) + 1]; const float o1 = x1[e] * cx - x2[e] * cy, o2 = x2[e] * cx + x1[e] * cy; x1[e] = o1; x2[e] = o2; }
      }
      u32x2 w1, w2; w1.x = pk2(x1[0] * sc, x1[1] * sc); w1.y = pk2(x1[2] * sc, x1[3] * sc); w2.x = pk2(x2[0] * sc, x2[1] * sc); w2.y = pk2(x2[2] * sc, x2[3] * sc);
      *(u32x2*)base = w1; *(u32x2*)(base + 32) = w2;
    }
    if ((lane >> 2) >= 8) {
      const int grp = lane >> 2, sub = lane & 3; bf16_t* base = q + 1024 + grp * 32 + 4 * sub;
      const u32x2 a = w.da, bb = w.db;
      float x1[4] = {bflo(a.x), bfhi(a.x), bflo(a.y), bfhi(a.y)}, x2[4] = {bflo(bb.x), bfhi(bb.x), bflo(bb.y), bfhi(bb.y)};
      float ss = 0.f;
#pragma unroll
      for (int e = 0; e < 4; ++e) ss += x1[e] * x1[e] + x2[e] * x2[e];
      ss += sx(ss, 1); ss += sx(ss, 2);
      const float rstd = rsqrtf(ss * (1.0f / 32.0f) + EPS);
#pragma unroll
      for (int e = 0; e < 4; ++e) { x1[e] = x1[e] * rstd * gd1[e]; x2[e] = x2[e] * rstd * gd2[e]; }
      if (!lat && grp >= 8) { float* o = p.out + O_DK + obase * 256 + (grp - 8) * 32 + 4 * sub;
        *(f32x4*)o = (f32x4){x1[0], x1[1], x1[2], x1[3]}; *(f32x4*)(o + 16) = (f32x4){x2[0], x2[1], x2[2], x2[3]}; }
      if (lat) {
#pragma unroll
        for (int e = 0; e < 4; ++e) { const float cx = w.t32[e >> 1][2 * (e & 1)], cy = w.t32[e >> 1][2 * (e & 1) + 1]; const float o1 = x1[e] * cx - x2[e] * cy, o2 = x2[e] * cx + x1[e] * cy; x1[e] = o1; x2[e] = o2; }
      }
      const float sc = grp < 8 ? qscale_d : 1.0f;
      u32x2 w1, w2; w1.x = pk2(x1[0] * sc, x1[1] * sc); w1.y = pk2(x1[2] * sc, x1[3] * sc); w2.x = pk2(x2[0] * sc, x2[1] * sc); w2.y = pk2(x2[2] * sc, x2[3] * sc);
      *(u32x2*)base = w1; *(u32x2*)(base + 16) = w2;
    }
    if (!lat) {
      const u32x2 a = w.dv;
      *(f32x4*)(p.out + O_DV + obase * 256 + lane * 4) = (f32x4){bflo(a.x), bfhi(a.x), bflo(a.y), bfhi(a.y)};
    }
    {
      bf16_t* ck = CKV + (size_t)r * LCKV + lane * 4; const u32x2 a = w.ck; float x[4] = {bflo(a.x), bfhi(a.x), bflo(a.y), bfhi(a.y)};
      float ss = x[0] * x[0] + x[1] * x[1] + x[2] * x[2] + x[3] * x[3]; ss = wave_sum(ss); const float rstd = rsqrtf(ss * (1.0f / 256.0f) + EPS);
      const f32x4 g = gkv;
      const f32x4 y = (f32x4){x[0] * rstd * g[0], x[1] * rstd * g[1], x[2] * rstd * g[2], x[3] * rstd * g[3]};
      u32x2 wv; wv.x = pk2(y[0], y[1]); wv.y = pk2(y[2], y[3]); *(u32x2*)ck = wv;
      if (!lat) *(f32x4*)(p.out + O_CKV + obase * 256 + lane * 4) = y;
    }
    if (!lat && lane < 32) p.out[O_KR + obase * 32 + lane] = w.kr;
  };
  int rstride = gridDim.x * 8; asm volatile("" : "+s"(rstride));
  for (int r0 = blockIdx.x * 8 + wid; r0 < NTOK; r0 += 3 * rstride) {
    Raw A, B, C; const bool h1 = r0 + rstride < NTOK, h2 = r0 + 2 * rstride < NTOK;
    load_row(r0, A); if (h1) load_row(r0 + rstride, B); if (h2) load_row(r0 + 2 * rstride, C);
    finish_row(r0, A); if (h1) finish_row(r0 + rstride, B); if (h2) finish_row(r0 + 2 * rstride, C);
  }
}

DI void ret_u_items(const Params& p, int l, LAS unsigned char* lds) {
  const int tid = otid(), lane = tid & 63, wid = tid >> 6, r = lane & 31, h = lane >> 5, q4 = (lane & 15) >> 2, p4 = lane & 3, g = (lane >> 4) & 1;
  const bf16_t* QKV = (const bf16_t*)(p.ws + OFF_QKV); float* U = (float*)(p.ws + OFF_U);
  const float* sc = (const float*)(p.ws + OFF_SCAL) + l * 16;
  for (int it = blockIdx.x; it < 1280; it += gridDim.x) {
    const int hd = it & 3, scn = it >> 2; int rowbase, ubase, ustride_dir;
    if (scn < 64) { const int b = scn >> 1, ch = scn & 1; rowbase = b * 256 + ch * 128; ubase = ((b * 4 + hd) * 2) * 2 + ch; ustride_dir = 2; }
    else { const int s2 = scn - 64, b = s2 >> 5, ch = s2 & 31; rowbase = NCTX + b * 4096 + ch * 128; ubase = 512 + ((b * 4 + hd) * 2) * 32 + ch; ustride_dir = 32; }
#pragma unroll
    for (int i = 0; i < 2; ++i) { const int id = tid + i * 512, row = id >> 3, cc = id & 7; const bf16_t* src = QKV + (size_t)(rowbase + row) * LQKV + hd * 64 + cc * 8;
      const u32x4 kv = *(const u32x4*)(src + 256), vv = *(const u32x4*)(src + 512);
      *(LAS u32x4*)(lds + row * 144 + cc * 16) = kv; *(LAS u32x4*)(lds + 18432 + row * 144 + cc * 16) = vv; }
    __syncthreads();
    const int dir = wid >> 2, dkt = (wid >> 1) & 1, dvt = wid & 1; const float lg = sc[4 + dir * 4 + hd];
    f32x16 acc; for (int i = 0; i < 16; ++i) acc[i] = 0.f;
#pragma unroll
    for (int s = 0; s < 8; ++s) {
      LAS unsigned char* ka = lds + (16 * s + 8 * h + q4) * 144 + (dkt * 32 + 16 * g + 4 * p4) * 2;
      LAS unsigned char* va = lds + 18432 + (16 * s + 8 * h + q4) * 144 + (dvt * 32 + 16 * g + 4 * p4) * 2;
      const bf16x8 kf = cat8(tr_read(ka), tr_read(ka + 4 * 144)); const bf16x8 vf = cat8(tr_read(va), tr_read(va + 4 * 144));
      const u32x4 ku = __builtin_bit_cast(u32x4, kf); float kx[8] = {bflo(ku.x), bfhi(ku.x), bflo(ku.y), bfhi(ku.y), bflo(ku.z), bfhi(ku.z), bflo(ku.w), bfhi(ku.w)};
#pragma unroll
      for (int j = 0; j < 8; ++j) { const int m = 16 * s + 8 * h + j; const float w = fast_exp2((dir ? (float)m : (float)(127 - m)) * lg); kx[j] *= w; }
      u32x4 kw; kw.x = pk2(kx[0], kx[1]); kw.y = pk2(kx[2], kx[3]); kw.z = pk2(kx[4], kx[5]); kw.w = pk2(kx[6], kx[7]);
      acc = MFMA32(__builtin_bit_cast(bf16x8, kw), vf, acc);
    }
    float* up = U + (size_t)(ubase + dir * ustride_dir) * 4096;
#pragma unroll
    for (int i = 0; i < 16; ++i) up[(dkt * 32 + crow(i, h)) * 64 + dvt * 32 + r] = acc[i];
    __syncthreads();
  }
}

DI void phase_post2(const Params& p, int l) {
  const int tid = otid(), lane = tid & 63, wid = tid >> 6;
  bf16_t* MQ = (bf16_t*)(p.ws + OFF_MQ); bf16_t* KV = (bf16_t*)(p.ws + OFF_KV); const bf16_t* KR = (const bf16_t*)(p.ws + OFF_KR);
  const float2* r32 = (const float2*)(p.ws + OFF_ROPE32);
  const float qscale = 0.10206207261596575f * LOG2E;
  const int hh = lane >> 3, sub = lane & 7;
  const float* gq = p.mla_qk_gain + l * 192; const float* gk = gq + 96;
  struct Raw2 { u32x4 qa; unsigned q1, q2; u32x4 ka; unsigned k1, k2; f32x4 cs; float ssq; };
  float gq8[8], gq1[2], gq2[2], gk8[8], gk1[2], gk2[2];
#pragma unroll
  for (int e = 0; e < 8; ++e) { gq8[e] = gq[8 * sub + e]; gk8[e] = gk[8 * sub + e]; }
#pragma unroll
  for (int e = 0; e < 2; ++e) { gq1[e] = gq[64 + 2 * sub + e]; gq2[e] = gq[80 + 2 * sub + e]; gk1[e] = gk[64 + 2 * sub + e]; gk2[e] = gk[80 + 2 * sub + e]; }
  auto load_row = [&](int r, Raw2& w) {
    const bf16_t* kb = KV + (size_t)r * LKV + hh * 160; w.ka = *(const u32x4*)(kb + 8 * sub);
    w.k1 = *(const unsigned*)(KR + (size_t)r * LKR + 2 * sub); w.k2 = *(const unsigned*)(KR + (size_t)r * LKR + 16 + 2 * sub);
    w.cs = (f32x4){1.f, 0.f, 1.f, 0.f}; if (r >= NCTX && r < NTOK) w.cs = *(const f32x4*)(r32 + ((r - NCTX) & 4095) * 16 + 2 * sub);
  };
  auto finish_row = [&](int r, const Raw2& w) {
    const bool lat = (r >= NCTX && r < NTOK); const int t = (r - NCTX) & 4095;
    const float2 cs[2] = {make_float2(w.cs[0], w.cs[1]), make_float2(w.cs[2], w.cs[3])}; (void)lat; (void)t;
    {
      bf16_t* base = KV + (size_t)r * LKV + hh * 160; const u32x4 a = w.ka; const unsigned b1 = w.k1, b2 = w.k2;
      float x[8] = {bflo(a.x), bfhi(a.x), bflo(a.y), bfhi(a.y), bflo(a.z), bfhi(a.z), bflo(a.w), bfhi(a.w)}; float y1[2] = {bflo(b1), bfhi(b1)}, y2[2] = {bflo(b2), bfhi(b2)};
      float ss = y1[0] * y1[0] + y1[1] * y1[1] + y2[0] * y2[0] + y2[1] * y2[1];
#pragma unroll
      for (int e = 0; e < 8; ++e) ss += x[e] * x[e];
      ss += sx(ss, 1); ss += sx(ss, 2); ss += sx(ss, 4);
      const float rstd = rsqrtf(ss * (1.0f / 96.0f) + EPS);
#pragma unroll
      for (int e = 0; e < 8; ++e) x[e] = x[e] * rstd * gk8[e];
#pragma unroll
      for (int e = 0; e < 2; ++e) { const float a1 = y1[e] * rstd * gk1[e], a2 = y2[e] * rstd * gk2[e];
        y1[e] = a1 * cs[e].x - a2 * cs[e].y; y2[e] = a2 * cs[e].x + a1 * cs[e].y; }
      u32x4 wv; wv.x = pk2(x[0], x[1]); wv.y = pk2(x[2], x[3]); wv.z = pk2(x[4], x[5]); wv.w = pk2(x[6], x[7]);
      *(u32x4*)(base + 8 * sub) = wv; *(unsigned*)(base + 64 + 2 * sub) = pk2(y1[0], y1[1]); *(unsigned*)(base + 80 + 2 * sub) = pk2(y2[0], y2[1]);
    }
  };
  int rstride = gridDim.x * 8; asm volatile("" : "+s"(rstride));
  for (int r0 = blockIdx.x * 8 + wid; r0 < NKVROWS; r0 += 4 * rstride) {
    Raw2 A, B, C, E; const bool h1 = r0 + rstride < NKVROWS, h2 = r0 + 2 * rstride < NKVROWS, h3 = r0 + 3 * rstride < NKVROWS;
    load_row(r0, A); if (h1) load_row(r0 + rstride, B); if (h2) load_row(r0 + 2 * rstride, C); if (h3) load_row(r0 + 3 * rstride, E);
    finish_row(r0, A); if (h1) finish_row(r0 + rstride, B); if (h2) finish_row(r0 + 2 * rstride, C); if (h3) finish_row(r0 + 3 * rstride, E);
  }
  float* U = (float*)(p.ws + OFF_U); const float* sc = (const float*)(p.ws + OFF_SCAL) + l * 16;
  const int gtid = blockIdx.x * 512 + tid, gsz = ogsz();
  for (int i = gtid; i < 262144; i += gsz) {
    const int e = i & 4095, sd = i >> 12, dir = sd & 1, bh = sd >> 1, hd = bh & 3, b = bh >> 2;
    float* up = U + (size_t)(512 + (bh * 2 + dir) * 32) * 4096 + e;
    const float gC = fast_exp2(128.0f * sc[4 + dir * 4 + hd]);
    float S = p.state_ret[((size_t)((b * 4 + l) * 2 + dir) * 4 + hd) * 4096 + e];
    float u[32];
#pragma unroll
    for (int c = 0; c < 32; ++c) u[c] = up[(size_t)c * 4096];
    if (dir == 0) {
#pragma unroll
      for (int c = 0; c < 32; ++c) { up[(size_t)c * 4096] = S; S = gC * S + u[c]; } }
    else {
#pragma unroll
      for (int c = 31; c >= 0; --c) { up[(size_t)c * 4096] = S; S = gC * S + u[c]; } }
  }
  for (int i0 = gtid; i0 < 1048576; i0 += 4 * gsz) {
    float u0[4], u1[4];
#pragma unroll
    for (int k = 0; k < 4; ++k) { const int i = i0 + k * gsz; if (i < 1048576) { const int e = i & 4095, sd = i >> 12; const float* up = U + (size_t)(sd * 2) * 4096 + e; u0[k] = up[0]; u1[k] = up[4096]; } }
#pragma unroll
    for (int k = 0; k < 4; ++k) { const int i = i0 + k * gsz; if (i < 1048576) { const int e = i & 4095, sd = i >> 12, dir = sd & 1, bh = sd >> 1, hd = bh & 3, b = bh >> 2;
      float* up = U + (size_t)(sd * 2) * 4096 + e; const float gC = fast_exp2(128.0f * sc[4 + dir * 4 + hd]); float S;
      if (dir == 0) { up[0] = 0.f; up[4096] = u0[k]; S = gC * u0[k] + u1[k]; }
      else { up[4096] = 0.f; up[0] = u1[k]; S = gC * u1[k] + u0[k]; }
      p.out[O_STATE + ((size_t)((b * 4 + l) * 2 + dir) * 4 + hd) * 4096 + e] = S; } }
  }
}

struct NoQFix { template <int NM, int NK> DI void operator()(bf16x8 (&)[NM][NK], int, int) const {} };
struct MlaQFix {
  const float* ssq; const float* gq; const float2* r32; int lat; int t0; float qscale;
  DI void operator()(bf16x8 (&q)[1][6], int qrow, int h) const {
    const float sq = ssq[qrow];
    f32x4 g[6][2];
#pragma unroll
    for (int ks = 0; ks < 6; ++ks) { g[ks][0] = *(const f32x4*)(gq + ks * 16 + 8 * h); g[ks][1] = *(const f32x4*)(gq + ks * 16 + 8 * h + 4); }
    f32x4 tb[4];
    if (lat) { const f32x4* tp = (const f32x4*)(r32 + (size_t)(t0 + qrow) * 16 + 8 * h);
#pragma unroll
      for (int i = 0; i < 4; ++i) tb[i] = tp[i]; }
    float x[6][8]; float ss = 0.f;
#pragma unroll
    for (int ks = 0; ks < 6; ++ks) { const u32x4 u = __builtin_bit_cast(u32x4, q[0][ks]);
#pragma unroll
      for (int m = 0; m < 4; ++m) { x[ks][2 * m] = bflo(u[m]); x[ks][2 * m + 1] = bfhi(u[m]); ss += x[ks][2 * m] * x[ks][2 * m] + x[ks][2 * m + 1] * x[ks][2 * m + 1]; } }
    ss += sx(ss, 32);
    const float rstd = rsqrtf(ss * (1.0f / 96.0f) + EPS * (sq * (1.0f / 768.0f) + EPS));
#pragma unroll
    for (int ks = 0; ks < 6; ++ks)
#pragma unroll
      for (int j = 0; j < 8; ++j) x[ks][j] *= rstd * g[ks][j >> 2][j & 3];
    if (lat) {
#pragma unroll
      for (int j = 0; j < 8; ++j) { const float cx = tb[j >> 1][2 * (j & 1)], cy = tb[j >> 1][2 * (j & 1) + 1]; const float a1 = x[4][j], a2 = x[5][j]; x[4][j] = a1 * cx - a2 * cy; x[5][j] = a2 * cx + a1 * cy; }
    }
#pragma unroll
    for (int ks = 0; ks < 6; ++ks) { u32x4 w;
#pragma unroll
      for (int m = 0; m < 4; ++m) w[m] = pk2(x[ks][2 * m] * qscale, x[ks][2 * m + 1] * qscale);
      q[0][ks] = __builtin_bit_cast(bf16x8, w); }
  }
};
struct DiffQFix {
  const float* gq; const float2* r32; int lat; int t0; float qscale;
  DI void operator()(bf16x8 (&q)[2][2], int qrow, int h) const {
    f32x4 g[2][2];
#pragma unroll
    for (int ks = 0; ks < 2; ++ks) { g[ks][0] = *(const f32x4*)(gq + ks * 16 + 8 * h); g[ks][1] = *(const f32x4*)(gq + ks * 16 + 8 * h + 4); }
    f32x4 tb[4];
    if (lat) { const f32x4* tp = (const f32x4*)(r32 + (size_t)(t0 + qrow) * 16 + 8 * h);
#pragma unroll
      for (int i = 0; i < 4; ++i) tb[i] = tp[i]; }
#pragma unroll
    for (int mp = 0; mp < 2; ++mp) {
      float x[2][8]; float ss = 0.f;
#pragma unroll
      for (int ks = 0; ks < 2; ++ks) { const u32x4 u = __builtin_bit_cast(u32x4, q[mp][ks]);
#pragma unroll
        for (int m = 0; m < 4; ++m) { x[ks][2 * m] = bflo(u[m]); x[ks][2 * m + 1] = bfhi(u[m]); ss += x[ks][2 * m] * x[ks][2 * m] + x[ks][2 * m + 1] * x[ks][2 * m + 1]; } }
      ss += sx(ss, 32);
      const float rstd = rsqrtf(ss * (1.0f / 32.0f) + EPS);
#pragma unroll
      for (int ks = 0; ks < 2; ++ks)
#pragma unroll
        for (int j = 0; j < 8; ++j) x[ks][j] *= rstd * g[ks][j >> 2][j & 3];
      if (lat) {
#pragma unroll
        for (int j = 0; j < 8; ++j) { const float cx = tb[j >> 1][2 * (j & 1)], cy = tb[j >> 1][2 * (j & 1) + 1]; const float a1 = x[0][j], a2 = x[1][j]; x[0][j] = a1 * cx - a2 * cy; x[1][j] = a2 * cx + a1 * cy; }
      }
#pragma unroll
      for (int ks = 0; ks < 2; ++ks) { u32x4 w;
#pragma unroll
        for (int m = 0; m < 4; ++m) w[m] = pk2(x[ks][2 * m] * qscale, x[ks][2 * m + 1] * qscale);
        q[mp][ks] = __builtin_bit_cast(bf16x8, w); }
    }
  }
};
template <int DQK, int NMAP, bool ONES, class QF>
DI void attn_item(LAS unsigned char* lds, const bf16_t* Q, int ldq,
                  const bf16_t* K0, const bf16_t* V0, int ldk0, int ldv0, int nt0,
                  const bf16_t* K1, const bf16_t* V1, int ldk1, int ldv1, int nt1,
                  float Mb2, float (&lsum)[NMAP], f32x16 (&accO)[NMAP][2], const QF& qfix) {
  constexpr int KW = NMAP * DQK, KS = KW + 8, VS = 72, CPRK = KW / 8, NK = 128 * CPRK / 512, KBYTES = 128 * KS * 2, BUFSZ = KBYTES + 128 * VS * 2, NKS = DQK / 16, NU = 4 * NMAP;
  const int tid_ = otid();
  const int tid = tid_, lane = tid & 63, wid = tid >> 6, r = lane & 31, h = lane >> 5, q4 = (lane & 15) >> 2, p4 = lane & 3, g = (lane >> 4) & 1;
  bf16x8 qreg[NMAP][NKS];
#pragma unroll
  for (int mp = 0; mp < NMAP; ++mp)
#pragma unroll
    for (int ks = 0; ks < NKS; ++ks) qreg[mp][ks] = *(const bf16x8*)(Q + (size_t)(wid * 32 + r) * ldq + mp * DQK + ks * 16 + 8 * h);
  qfix(qreg, wid * 32 + r, h);
  f32x16 accL[NMAP];
#pragma unroll
  for (int mp = 0; mp < NMAP; ++mp) { lsum[mp] = 0.f;
#pragma unroll
    for (int i = 0; i < 16; ++i) { accO[mp][0][i] = 0.f; accO[mp][1][i] = 0.f; accL[mp][i] = 0.f; } }
  const bf16x8 ones = {(short)0x3F80, (short)0x3F80, (short)0x3F80, (short)0x3F80, (short)0x3F80, (short)0x3F80, (short)0x3F80, (short)0x3F80};
  const int nt = nt0 + nt1;
  const int koff = r * (KS * 2) + 16 * h;
  const int voff = (4 * h + q4) * (VS * 2) + (16 * g + 4 * p4) * 2;
  u32x4 kst[NK], vst[2];
  auto gload = [&](int t) {
    const bf16_t* Kp; const bf16_t* Vp; int ldk, ldv;
    if (t < nt0) { Kp = K0 + (size_t)t * 128 * ldk0; Vp = V0 + (size_t)t * 128 * ldv0; ldk = ldk0; ldv = ldv0; }
    else { Kp = K1 + (size_t)(t - nt0) * 128 * ldk1; Vp = V1 + (size_t)(t - nt0) * 128 * ldv1; ldk = ldk1; ldv = ldv1; }
#pragma unroll
    for (int i = 0; i < NK; ++i) { const int id = tid + i * 512, row = id / CPRK, cc = id % CPRK; kst[i] = *(const u32x4*)(Kp + (size_t)row * ldk + cc * 8); }
#pragma unroll
    for (int i = 0; i < 2; ++i) { const int id = tid + i * 512, row = id >> 3, cc = id & 7; vst[i] = *(const u32x4*)(Vp + (size_t)row * ldv + cc * 8); }
  };
  auto lstore = [&](LAS unsigned char* kb) {
    LAS unsigned char* vb = kb + KBYTES;
#pragma unroll
    for (int i = 0; i < NK; ++i) { const int id = tid + i * 512, row = id / CPRK, cc = id % CPRK; *(LAS u32x4*)(kb + row * (KS * 2) + cc * 16) = kst[i]; }
#pragma unroll
    for (int i = 0; i < 2; ++i) { const int id = tid + i * 512, row = id >> 3, cc = id & 7; *(LAS u32x4*)(vb + row * (VS * 2) + cc * 16) = vst[i]; }
  };
  auto QK = [&](LAS unsigned char* kb, int st, int mp, f32x16& s) {
#pragma unroll
    for (int i = 0; i < 16; ++i) s[i] = -Mb2;
#pragma unroll
    for (int ks = 0; ks < NKS; ++ks) { const bf16x8 kf = *(const LAS bf16x8*)(kb + st * 32 * (KS * 2) + koff + (mp * DQK + ks * 16) * 2); s = MFMA32(kf, qreg[mp][ks], s); }
  };
  auto PV = [&](LAS unsigned char* kb, int st, int mp, const bf16x8& pb0, const bf16x8& pb1) {
    LAS unsigned char* vb = kb + KBYTES + st * 32 * (VS * 2) + voff;
#pragma unroll
    for (int dvt = 0; dvt < 2; ++dvt) {
      LAS unsigned char* va = vb + dvt * 64;
      const bf16x8 vf0 = cat8(tr_read(va), tr_read(va + 8 * VS * 2)), vf1 = cat8(tr_read(va + 16 * VS * 2), tr_read(va + 24 * VS * 2));
      accO[mp][dvt] = MFMA32(vf0, pb0, accO[mp][dvt]); accO[mp][dvt] = MFMA32(vf1, pb1, accO[mp][dvt]);
    }
    if (ONES) { accL[mp] = MFMA32(ones, pb0, accL[mp]); accL[mp] = MFMA32(ones, pb1, accL[mp]); }
  };
  auto EXPK = [&](f32x16& s, int mp, bf16x8& pb0, bf16x8& pb1) {
    float ps = 0.f;
#pragma unroll
    for (int i = 0; i < 16; ++i) { s[i] = fast_exp2(s[i]); if (!ONES) ps += s[i]; }
    if (!ONES) lsum[mp] += ps;
    u32x4 p0, p1; p0.x = pk2(s[0], s[1]); p0.y = pk2(s[2], s[3]); p0.z = pk2(s[4], s[5]); p0.w = pk2(s[6], s[7]);
    p1.x = pk2(s[8], s[9]); p1.y = pk2(s[10], s[11]); p1.z = pk2(s[12], s[13]); p1.w = pk2(s[14], s[15]);
    pb0 = __builtin_bit_cast(bf16x8, p0); pb1 = __builtin_bit_cast(bf16x8, p1);
  };
  gload(0); lstore(lds);
  if (nt > 1) gload(1);
  __syncthreads();
  f32x16 s_next, s_cur; bf16x8 pp0, pp1;
  QK(lds, 0, 0, s_next);
  int bcur = 0, bprev = 2;
  for (int t = 0; t < nt; ++t) {
    const int bnext = bcur == 2 ? 0 : bcur + 1;
    LAS unsigned char* kbc = lds + bcur * BUFSZ; LAS unsigned char* kbp = lds + bprev * BUFSZ; LAS unsigned char* kbn = lds + bnext * BUFSZ;
#pragma unroll
    for (int u = 0; u < NU; ++u) {
      if (u == NU - 1) {
        if (t + 1 < nt) { lstore(kbn); if (t + 2 < nt) gload(t + 2); }
        __syncthreads();
      }
#pragma unroll
      for (int i = 0; i < 16; ++i) s_cur[i] = s_next[i];
      if (u < NU - 1) QK(kbc, (u + 1) / NMAP, (u + 1) % NMAP, s_next);
      else if (t + 1 < nt) QK(kbn, 0, 0, s_next);
      if (u > 0) PV(kbc, (u - 1) / NMAP, (u - 1) % NMAP, pp0, pp1);
      else if (t > 0) PV(kbp, 3, NMAP - 1, pp0, pp1);
      EXPK(s_cur, u % NMAP, pp0, pp1);
    }
    bprev = bcur; bcur = bnext;
  }
  PV(lds + bprev * BUFSZ, 3, NMAP - 1, pp0, pp1);
#pragma unroll
  for (int mp = 0; mp < NMAP; ++mp) { if (ONES) lsum[mp] = accL[mp][0]; else lsum[mp] += sx(lsum[mp], 32); }
  __syncthreads();
}

DI void mla_item(const Params& p, int l, LAS unsigned char* lds, bool lat, int b, int hd, int qb) {
  const int tid_ = otid();
  const int lane = tid_ & 63, wid = tid_ >> 6, r = lane & 31, h = lane >> 5;
  const bf16_t* MQ = (const bf16_t*)(p.ws + OFF_MQ); const bf16_t* KV = (const bf16_t*)(p.ws + OFF_KV); bf16_t* MIX = (bf16_t*)(p.ws + OFF_MIX);
  const float* sc = (const float*)(p.ws + OFF_SCAL) + l * 16;
  const int seq0 = lat ? NCTX + b * 4096 : b * 256; const int row0 = seq0 + qb * 256;
  float lsum[1]; f32x16 acc[1][2];
  const bf16_t* K0 = KV + (size_t)seq0 * LKV + hd * 160; const bf16_t* K1 = KV + (size_t)(NTOK + b * 256) * LKV + hd * 160;
  const MlaQFix qf{(const float*)(p.ws + OFF_SSQ) + row0, p.mla_qk_gain + l * 192, (const float2*)(p.ws + OFF_ROPE32), lat ? 1 : 0, row0 - seq0, 0.10206207261596575f * LOG2E};
  attn_item<96, 1, false>(lds, MQ + (size_t)row0 * LMQ + hd * 96, LMQ, K0, K0 + 96, LKV, LKV, lat ? 32 : 2, K1, K1 + 96, LKV, LKV, lat ? 2 : 0, sc[3], lsum, acc, qf);
  const float inv = 1.0f / lsum[0]; bf16_t* op = MIX + (size_t)(row0 + wid * 32 + r) * D + 512 + hd * 64;
#pragma unroll
  for (int dvt = 0; dvt < 2; ++dvt)
#pragma unroll
    for (int g4 = 0; g4 < 4; ++g4) { u32x2 w; w.x = pk2(acc[0][dvt][4 * g4] * inv, acc[0][dvt][4 * g4 + 1] * inv); w.y = pk2(acc[0][dvt][4 * g4 + 2] * inv, acc[0][dvt][4 * g4 + 3] * inv);
      *(u32x2*)(op + dvt * 32 + 8 * g4 + 4 * h) = w; }
}

DI void diff_item(const Params& p, int l, LAS unsigned char* lds, bool lat, int b, int hd, int qb) {
  const int tid_ = otid();
  const int lane = tid_ & 63, wid = tid_ >> 6, r = lane & 31, h = lane >> 5;
  const bf16_t* QKV = (const bf16_t*)(p.ws + OFF_QKV); const bf16_t* DKC = (const bf16_t*)(p.ws + OFF_DKC); const bf16_t* DVC = (const bf16_t*)(p.ws + OFF_DVC); bf16_t* MIX = (bf16_t*)(p.ws + OFF_MIX);
  const float* sc = (const float*)(p.ws + OFF_SCAL) + l * 16;
  const int seq0 = lat ? NCTX + b * 4096 : b * 256; const int row0 = seq0 + qb * 256;
  float lsum[2]; f32x16 acc[2][2];
  const bf16_t* K0 = QKV + (size_t)seq0 * LQKV + 1280 + hd * 64; const bf16_t* V0 = QKV + (size_t)seq0 * LQKV + 1536 + hd * 64;
  const bf16_t* K1 = DKC + (size_t)(b * 256) * 256 + hd * 64; const bf16_t* V1 = DVC + (size_t)(b * 256) * 256 + hd * 64;
  attn_item<32, 2, true>(lds, QKV + (size_t)row0 * LQKV + 1024 + hd * 64, LQKV, K0, V0, LQKV, LQKV, lat ? 32 : 2, K1, V1, 256, 256, lat ? 2 : 0, sc[2], lsum, acc, DiffQFix{p.diff_qk_gain + l * 64, (const float2*)(p.ws + OFF_ROPE32), lat ? 1 : 0, row0 - seq0, 0.17677669529663687f * LOG2E});
  const float lam = sc[0], oml = 1.0f - sc[1]; const float i0 = 1.0f / lsum[0], i1 = lam / lsum[1];
  float ss = 0.f;
#pragma unroll
  for (int dvt = 0; dvt < 2; ++dvt)
#pragma unroll
    for (int i = 0; i < 16; ++i) { const float o = acc[0][dvt][i] * i0 - acc[1][dvt][i] * i1; acc[0][dvt][i] = o; ss += o * o; }
  ss += sx(ss, 32); const float rstd = rsqrtf(ss * (1.0f / 64.0f) + EPS) * oml;
  const float* sg = p.diff_subln + l * 64; bf16_t* op = MIX + (size_t)(row0 + wid * 32 + r) * D + 256 + hd * 64;
#pragma unroll
  for (int dvt = 0; dvt < 2; ++dvt)
#pragma unroll
    for (int g4 = 0; g4 < 4; ++g4) { const int dv = dvt * 32 + 8 * g4 + 4 * h; const f32x4 gg = *(const f32x4*)(sg + dv);
      u32x2 w; w.x = pk2(acc[0][dvt][4 * g4] * rstd * gg[0], acc[0][dvt][4 * g4 + 1] * rstd * gg[1]); w.y = pk2(acc[0][dvt][4 * g4 + 2] * rstd * gg[2], acc[0][dvt][4 * g4 + 3] * rstd * gg[3]);
      *(u32x2*)(op + dv) = w; }
}

DI void ret_item(const Params& p, int l, LAS unsigned char* lds, bool lat, int b, int hd, int qb) {
  const int tid_ = otid();
  const int tid = tid_, lane = tid & 63, wid = tid >> 6, r = lane & 31, h = lane >> 5, q4 = (lane & 15) >> 2, p4 = lane & 3, g = (lane >> 4) & 1;
  const bf16_t* QKV = (const bf16_t*)(p.ws + OFF_QKV); const float* U = (const float*)(p.ws + OFF_U); bf16_t* MIX = (bf16_t*)(p.ws + OFF_MIX);
  const float* sc = (const float*)(p.ws + OFF_SCAL) + l * 16; const float lgf = sc[4 + hd], lgb = sc[8 + hd];
  const int seq0 = lat ? NCTX + b * 4096 : b * 256; const int row0 = seq0 + qb * 256;
  constexpr int KOFF = 0, VOFF = 36864, SOFF = 73728, RS = 144;
#pragma unroll
  for (int i = 0; i < 4; ++i) { const int id = tid + i * 512, row = id >> 3, cc = id & 7; const bf16_t* src = QKV + (size_t)(row0 + row) * LQKV + hd * 64 + cc * 8;
    const u32x4 kv = *(const u32x4*)(src + 256), vv = *(const u32x4*)(src + 512);
    *(LAS u32x4*)(lds + KOFF + row * RS + cc * 16) = kv; *(LAS u32x4*)(lds + VOFF + row * RS + cc * 16) = vv; }
#pragma unroll
  for (int i = 0; i < 8; ++i) { const int id = tid + i * 512, mat = id >> 10, e4 = id & 1023, ci = mat >> 1, dir = mat & 1; const int ch = qb * 2 + ci;
    const size_t uidx = lat ? (size_t)(512 + ((b * 4 + hd) * 2 + dir) * 32 + ch) : (size_t)(((b * 4 + hd) * 2 + dir) * 2 + ch);
    const f32x4 v = *(const f32x4*)(U + uidx * 4096 + e4 * 4); const int dk = e4 >> 4, dv = (e4 & 15) * 4;
    u32x2 w; w.x = pk2(v[0], v[1]); w.y = pk2(v[2], v[3]); *(LAS u32x2*)(lds + SOFF + mat * 9216 + dk * RS + dv * 2) = w; }
  const int ci = wid >> 2, n = (wid & 3) * 32 + r; const int row = row0 + ci * 128 + n;
  bf16x8 qreg[4];
#pragma unroll
  for (int ks = 0; ks < 4; ++ks) qreg[ks] = *(const bf16x8*)(QKV + (size_t)row * LQKV + hd * 64 + ks * 16 + 8 * h);
  if (lat) {
    const f32x4* tp = (const f32x4*)((const float2*)(p.ws + OFF_ROPE64) + (size_t)(row - seq0) * 32 + 8 * h);
    f32x4 tb[2][4];
#pragma unroll
    for (int ks = 0; ks < 2; ++ks)
#pragma unroll
      for (int i = 0; i < 4; ++i) tb[ks][i] = tp[ks * 8 + i];
#pragma unroll
    for (int ks = 0; ks < 2; ++ks) { const u32x4 ua = __builtin_bit_cast(u32x4, qreg[ks]), ub = __builtin_bit_cast(u32x4, qreg[ks + 2]); u32x4 wa, wb;
#pragma unroll
      for (int m = 0; m < 4; ++m) { const float a0 = bflo(ua[m]), a1 = bfhi(ua[m]), b0 = bflo(ub[m]), b1 = bfhi(ub[m]);
        const float c0 = tb[ks][m][0], s0 = tb[ks][m][1], c1 = tb[ks][m][2], s1 = tb[ks][m][3];
        wa[m] = pk2(a0 * c0 - b0 * s0, a1 * c1 - b1 * s1); wb[m] = pk2(b0 * c0 + a0 * s0, b1 * c1 + a1 * s1); }
      qreg[ks] = __builtin_bit_cast(bf16x8, wa); qreg[ks + 2] = __builtin_bit_cast(bf16x8, wb); }
  }
  __syncthreads();
  f32x16 accO[2], accF[2], accB[2];
#pragma unroll
  for (int d = 0; d < 2; ++d)
#pragma unroll
    for (int i = 0; i < 16; ++i) { accO[d][i] = 0.f; accF[d][i] = 0.f; accB[d][i] = 0.f; }
#pragma unroll
  for (int kt = 0; kt < 4; ++kt) {
    f32x16 s; for (int i = 0; i < 16; ++i) s[i] = 0.f;
#pragma unroll
    for (int ks = 0; ks < 4; ++ks) { const bf16x8 kf = *(const LAS bf16x8*)(lds + KOFF + (ci * 128 + kt * 32 + r) * RS + (ks * 16 + 8 * h) * 2); s = MFMA32(kf, qreg[ks], s); }
#pragma unroll
    for (int i = 0; i < 16; ++i) { const int m = kt * 32 + crow(i, h); const int d = n - m; const float w = d > 0 ? fast_exp2((float)d * lgf) : (d < 0 ? fast_exp2((float)(-d) * lgb) : 2.0f); s[i] *= w; }
    u32x4 p0, p1; p0.x = pk2(s[0], s[1]); p0.y = pk2(s[2], s[3]); p0.z = pk2(s[4], s[5]); p0.w = pk2(s[6], s[7]);
    p1.x = pk2(s[8], s[9]); p1.y = pk2(s[10], s[11]); p1.z = pk2(s[12], s[13]); p1.w = pk2(s[14], s[15]);
    const bf16x8 pb0 = __builtin_bit_cast(bf16x8, p0), pb1 = __builtin_bit_cast(bf16x8, p1);
#pragma unroll
    for (int dvt = 0; dvt < 2; ++dvt) {
      LAS unsigned char* va = lds + VOFF + (ci * 128 + kt * 32 + 4 * h + q4) * RS + (dvt * 32 + 16 * g + 4 * p4) * 2;
      const bf16x8 v0 = cat8(tr_read(va), tr_read(va + 8 * RS)); const bf16x8 v1 = cat8(tr_read(va + 16 * RS), tr_read(va + 24 * RS));
      accO[dvt] = MFMA32(v0, pb0, accO[dvt]); accO[dvt] = MFMA32(v1, pb1, accO[dvt]); }
  }
#pragma unroll
  for (int ks = 0; ks < 4; ++ks)
#pragma unroll
    for (int dvt = 0; dvt < 2; ++dvt) {
      LAS unsigned char* sa = lds + SOFF + (ci * 2) * 9216 + (16 * ks + 8 * h + q4) * RS + (dvt * 32 + 16 * g + 4 * p4) * 2;
      const bf16x8 sf = cat8(tr_read(sa), tr_read(sa + 4 * RS)); const bf16x8 sb = cat8(tr_read(sa + 9216), tr_read(sa + 9216 + 4 * RS));
      accF[dvt] = MFMA32(sf, qreg[ks], accF[dvt]); accB[dvt] = MFMA32(sb, qreg[ks], accB[dvt]); }
  const float af = fast_exp2((float)(n + 1) * lgf), ab = fast_exp2((float)(128 - n) * lgb);
  float sum = 0.f;
#pragma unroll
  for (int dvt = 0; dvt < 2; ++dvt)
#pragma unroll
    for (int i = 0; i < 16; ++i) { const float o = accO[dvt][i] + af * accF[dvt][i] + ab * accB[dvt][i]; accO[dvt][i] = o; sum += o; }
  sum += sx(sum, 32); const float mu = sum * (1.0f / 64.0f); float var = 0.f;
#pragma unroll
  for (int dvt = 0; dvt < 2; ++dvt)
#pragma unroll
    for (int i = 0; i < 16; ++i) { const float dlt = accO[dvt][i] - mu; accO[dvt][i] = dlt; var += dlt * dlt; }
  var += sx(var, 32); const float rstd = rsqrtf(var * (1.0f / 64.0f) + EPS);
  const float* gn = p.ret_gn + l * 256 + hd * 64; const bf16_t* rg = QKV + (size_t)row * LQKV + 768 + hd * 64; bf16_t* op = MIX + (size_t)row * D + hd * 64;
#pragma unroll
  for (int dvt = 0; dvt < 2; ++dvt)
#pragma unroll
    for (int g4 = 0; g4 < 4; ++g4) { const int dv = dvt * 32 + 8 * g4 + 4 * h; const f32x4 gg = *(const f32x4*)(gn + dv); const u32x2 ga = *(const u32x2*)(rg + dv);
      const float gt[4] = {bflo(ga.x), bfhi(ga.x), bflo(ga.y), bfhi(ga.y)}; float y[4];
#pragma unroll
      for (int j = 0; j < 4; ++j) { const float sl = gt[j] * __builtin_amdgcn_rcpf(1.0f + __expf(-gt[j])); y[j] = accO[dvt][4 * g4 + j] * rstd * gg[j] * sl; }
      u32x2 w; w.x = pk2(y[0], y[1]); w.y = pk2(y[2], y[3]); *(u32x2*)(op + dv) = w; }
  __syncthreads();
}

DI void phase_mixers(const Params& p, int l, LAS unsigned char* lds) {
  unsigned* cnt = (unsigned*)(p.ws + OFF_CNT) + l * 8; LAS unsigned* slot = (LAS unsigned*)(lds + LDS_CTL);
  const int myx = (int)((unsigned)__builtin_amdgcn_s_getreg((3 << 11) | 20) & 7u);
  for (;;) {
    if (otid() == 0) {
      unsigned got = 0xffffffffu;
      for (int k = 0; k < 8; ++k) { const int y = (myx + k) & 7; const unsigned idx = atomicAdd(cnt + y, 1u); if (idx < 320u) { got = (unsigned)y * 320u + idx; break; } }
      *slot = got;
    }
    __syncthreads();
    const int enc = __builtin_amdgcn_readfirstlane((int)*slot);
    __syncthreads();
    if (enc < 0) break;
    const int x = enc / 320, j = enc % 320;
    if (j < 64) { const int gi = (j >> 4) * 8 + x, qb = j & 15; diff_item(p, l, lds, true, gi >> 2, gi & 3, qb); }
    else if (j < 192) { const int jj = j - 64, gi = (jj >> 4) * 8 + x, qb = jj & 15; mla_item(p, l, lds, true, gi >> 3, gi & 7, qb); }
    else if (j < 256) { const int jj = j - 192, gi = (jj >> 4) * 8 + x, qb = jj & 15; ret_item(p, l, lds, true, gi >> 2, gi & 3, qb); }
    else if (j < 288) { const int gi = (j - 256) * 8 + x; mla_item(p, l, lds, false, gi >> 3, gi & 7, 0); }
    else if (j < 304) { const int gi = (j - 288) * 8 + x; diff_item(p, l, lds, false, gi >> 2, gi & 3, 0); }
    else { const int gi = (j - 304) * 8 + x; ret_item(p, l, lds, false, gi >> 2, gi & 3, 0); }
  }
}


#define XB_TMO      128
#define XB_XCNT(j)  (256  + 64 * (j))
#define XB_XSUB(j)  (1280 + 64 * (j))
#define XB_XGEN(j)  (2304 + 64 * (j))
#define XB_TOP      3328
#define XB_TOPGEN   3392
#define XCD_BAR_WORDS 3456
#define XB_SPIN_CAP (1u << 20)
DI unsigned xb_ld(unsigned* p)              { return __hip_atomic_load(p, __ATOMIC_RELAXED, __HIP_MEMORY_SCOPE_AGENT); }
DI unsigned xb_add(unsigned* p, unsigned v) { return __hip_atomic_fetch_add(p, v, __ATOMIC_RELAXED, __HIP_MEMORY_SCOPE_AGENT); }
DI unsigned xb_xcc_id() { return (unsigned)__builtin_amdgcn_s_getreg((3 << 11) | 20) & 0xFu; }
#define XB_SPIN(cond, bar) do { unsigned _sp = 0; while (cond) { __builtin_amdgcn_s_sleep(1); \
    if ((++_sp & 255u) == 0u) { if (xb_ld(&(bar)[XB_TMO])) break; if (_sp > XB_SPIN_CAP) { atomicAdd(&(bar)[XB_TMO], 1u); break; } } } } while (0)
struct XcdBarrier { unsigned* bar; unsigned x; volatile LAS unsigned* st; };
DI XcdBarrier xcd_barrier_post(unsigned* bar, volatile LAS unsigned* st) {
  XcdBarrier b; b.bar = bar; b.x = xb_xcc_id(); b.st = st;
  if (threadIdx.x == 0) (void)xb_add(&bar[XB_XCNT(b.x)], 1u);
  return b;
}
DI void xcd_barrier_complete(unsigned* bar, unsigned x, unsigned& nloc, unsigned& nx) {
  const unsigned G = gridDim.x * gridDim.y * gridDim.z;
  unsigned sum, cnt, mine, sp = 0u;
  for (;;) {
    sum = 0u; cnt = 0u; mine = 0u;
#pragma unroll
    for (unsigned j = 0; j < 16; ++j) { const unsigned c = xb_ld(&bar[XB_XCNT(j)]); sum += c; cnt += (c > 0u) ? 1u : 0u; mine = (j == x) ? c : mine; }
    if (sum == G) break;
    __builtin_amdgcn_s_sleep(1);
    if ((++sp & 255u) == 0u) { if (xb_ld(&bar[XB_TMO])) break; if (sp > XB_SPIN_CAP) { atomicAdd(&bar[XB_TMO], 1u); break; } }
  }
  nloc = mine > 0u ? mine : 1u; nx = cnt > 0u ? cnt : 1u;
}
DI void xcd_barrier(const XcdBarrier& b) {
  asm volatile("s_waitcnt vmcnt(0)" ::: "memory");
  __syncthreads();
  if (threadIdx.x == 0) {
    unsigned* bar = b.bar;
    __builtin_amdgcn_s_waitcnt(0);
    unsigned nloc = b.st[0], nx = b.st[1];
    if (nloc == 0u) { xcd_barrier_complete(bar, b.x, nloc, nx); b.st[0] = nloc; b.st[1] = nx; }
    const unsigned old = xb_add(&bar[XB_XSUB(b.x)], 1u);
    const unsigned gen = old / nloc;
    if (old + 1u == (gen + 1u) * nloc) {
      __builtin_amdgcn_fence(__ATOMIC_RELEASE, "agent");
      asm volatile("s_waitcnt vmcnt(0)" ::: "memory");
      const unsigned og = xb_add(&bar[XB_TOP], 1u);
      const unsigned tg = og / nx;
      if (og + 1u == (tg + 1u) * nx) xb_add(&bar[XB_TOPGEN], 1u);
      else XB_SPIN(xb_ld(&bar[XB_TOPGEN]) == tg, bar);
      __builtin_amdgcn_fence(__ATOMIC_ACQUIRE, "agent");
      xb_add(&bar[XB_XGEN(b.x)], 1u);
      asm volatile("s_waitcnt vmcnt(0)" ::: "memory");
    } else {
      XB_SPIN(xb_ld(&bar[XB_XGEN(b.x)]) == gen, bar);
      __builtin_amdgcn_fence(__ATOMIC_ACQUIRE, "agent");
      asm volatile("s_waitcnt vmcnt(0)" ::: "memory");
    }
  }
  __syncthreads();
}

__global__ void __launch_bounds__(512, 2) fwd_megakernel(Params p) {
  extern __shared__ __attribute__((aligned(16))) unsigned char smem[];
  LAS unsigned char* lds = (LAS unsigned char*)smem;
  cg::grid_group grid = cg::this_grid();
  const int G = gridDim.x, c = blockIdx.x;
  unsigned char* ws = p.ws;
  volatile LAS unsigned* bst = (volatile LAS unsigned*)(lds + LDS_CTL + 16);
  if (threadIdx.x == 0) { bst[0] = 0u; bst[1] = 0u; }
  __syncthreads();
  XcdBarrier xbar; xbar.bar = (unsigned*)(ws + OFF_BAR); xbar.x = 0; xbar.st = bst;
  if (p.ph_hi - p.ph_lo > 1) xbar = xcd_barrier_post((unsigned*)(ws + OFF_BAR), bst);
  for (int ph = (int)p.ph_lo; ph < (int)p.ph_hi; ++ph) {
    if (ph == 0) phase0(p, lds);
    else {
      const int l = (ph - 1) / 10, s = (ph - 1) % 10;
      const float* modl = (const float*)(ws + OFF_MOD) + (size_t)l * 9 * 6144;
      pg8::StaticOrder S;
      if (s == 0) phase_norm(p, l, 0, lds);
      else if (s == 1) { pg8::Gemm g{(const bf16_t*)(ws + OFF_H), (const bf16_t*)(ws + OFF_WIN), NTOK, 3072, 1024, 1024}; S.init(g.M, g.N, G, c);
        EpiIn E{(bf16_t*)(ws + OFF_QKV), (bf16_t*)(ws + OFF_CQ), (bf16_t*)(ws + OFF_CKV), (bf16_t*)(ws + OFF_KR), (float*)(ws + OFF_SSQ)}; pg8::gemm_phase(lds, g, S, E); }
      else if (s == 2) phase_post1(p, l);
      else if (s == 3) {
        { pg8::Gemm g{(const bf16_t*)(ws + OFF_CQ), (const bf16_t*)(ws + OFF_WUQ), NTOK, 768, 768, 768}; S.init(g.M, g.N, G, c); EpiPlain E{(bf16_t*)(ws + OFF_MQ), LMQ}; pg8::gemm_phase(lds, g, S, E); }
        { pg8::Gemm g{(const bf16_t*)(ws + OFF_CKV), (const bf16_t*)(ws + OFF_WUKV), NKVROWS, 1024, 256, 256}; S.init(g.M, g.N, G, c); EpiKV E{(bf16_t*)(ws + OFF_KV)}; pg8::gemm_phase(lds, g, S, E); }
        __syncthreads();
        ret_u_items(p, l, lds);
      }
      else if (s == 4) phase_post2(p, l);
      else if (s == 5) phase_mixers(p, l, lds);
      else if (s == 6) { pg8::Gemm g{(const bf16_t*)(ws + OFF_MIX), (const bf16_t*)(ws + OFF_WOUT), NTOK, 1024, 1024, 1024}; S.init(g.M, g.N, G, c); EpiRes E{p.out, modl, 2048, l == 0 ? p.x_prompt : (const float*)nullptr, p.x_sample}; pg8::gemm_phase(lds, g, S, E); }
      else if (s == 7) phase_norm(p, l, 1, lds);
      else if (s == 8) { pg8::Gemm g{(const bf16_t*)(ws + OFF_H), (const bf16_t*)(ws + OFF_WGU), NTOK, 5632, 1024, 1024}; S.init(g.M, g.N, G, c); EpiGU E{(bf16_t*)(ws + OFF_ACT)}; pg8::gemm_phase(lds, g, S, E); }
      else { pg8::Gemm g{(const bf16_t*)(ws + OFF_ACT), (const bf16_t*)(ws + OFF_WDOWN), NTOK, 1024, 2816, 2816}; S.init(g.M, g.N, G, c); EpiRes E{p.out, modl, 5120, (const float*)nullptr, p.x_sample}; pg8::gemm_phase(lds, g, S, E); }
    }
    if (ph + 1 < (int)p.ph_hi) { if (p.ph_lo < 0) grid.sync(); xcd_barrier(xbar); }
  }
}

constexpr int NPHASES = 41;

extern "C" void kernel_launch(void* const* d_in, const int* in_sizes, int n_in, void* d_out, int out_size, void* d_ws, size_t ws_size, hipStream_t stream) {
  static int grid = 0;
  if (grid == 0) {
    if (n_in != 27 || ws_size < WS_END) { fprintf(stderr, "kernel_launch: unexpected n_in %d / ws_size %zu (need %zu)\n", n_in, ws_size, (size_t)WS_END); grid = -1; return; }
    int dev = 0, cus = 0, per_cu = 0;
    (void)hipGetDevice(&dev); (void)hipDeviceGetAttribute(&cus, hipDeviceAttributeMultiprocessorCount, dev);
    if (hipFuncSetAttribute((const void*)fwd_megakernel, hipFuncAttributeMaxDynamicSharedMemorySize, LDS_BYTES) != hipSuccess) { fprintf(stderr, "kernel_launch: hipFuncSetAttribute failed\n"); grid = -1; return; }
    if (hipOccupancyMaxActiveBlocksPerMultiprocessor(&per_cu, (const void*)fwd_megakernel, 512, LDS_BYTES) != hipSuccess || per_cu < 1) { fprintf(stderr, "kernel_launch: occupancy query gave %d\n", per_cu); per_cu = 1; }
    (void)hipGetLastError();
    grid = cus * 1;
  }
  if (grid < 0) return;
  (void)hipMemsetAsync((char*)d_ws + OFF_CNT, 0, 16384, stream);
  Params p{};
  const float** pp = (const float**)&p;
  for (int i = 0; i < 27; ++i) pp[i] = (const float*)d_in[i];
  p.out = (float*)d_out; p.ws = (unsigned char*)d_ws;
#if MK_COOP
  p.ph_lo = 0; p.ph_hi = NPHASES;
  void* args[] = {&p};
  hipError_t e = hipLaunchCooperativeKernel((const void*)fwd_megakernel, dim3(grid), dim3(512), args, LDS_BYTES, stream);
  if (e != hipSuccess) fprintf(stderr, "cooperative launch failed: %s (grid %d)\n", hipGetErrorString(e), grid);
#else
  for (int ph = 0; ph < NPHASES; ++ph) { p.ph_lo = ph; p.ph_hi = ph + 1; hipLaunchKernelGGL(fwd_megakernel, dim3(grid), dim3(512), LDS_BYTES, stream, p); }
#endif
}
```

```cpp
#include <hip/hip_runtime.h>
#include <hip/hip_cooperative_groups.h>
#include <cstdio>
namespace cg = cooperative_groups;

#ifndef MK_COOP
#define MK_COOP 1
#endif

#define LAS __attribute__((address_space(3)))
#define DI __device__ __forceinline__
typedef unsigned short bf16_t;
typedef short bf16x8 __attribute__((ext_vector_type(8)));
typedef short bf16x4 __attribute__((ext_vector_type(4)));
typedef float f32x4 __attribute__((ext_vector_type(4)));
typedef float f32x16 __attribute__((ext_vector_type(16)));
typedef unsigned u32x4 __attribute__((ext_vector_type(4)));
typedef unsigned u32x2 __attribute__((ext_vector_type(2)));
typedef __bf16 bf16v2 __attribute__((ext_vector_type(2)));

constexpr int D = 1024, NCTX = 8192, NLAT = 32768, NTOK = 40960, NKVROWS = 43008, NCACHE = 2048;
constexpr int LQKV = 1792, LCQ = 768, LCKV = 256, LKR = 32, LMQ = 768, LKV = 1280, DFF = 2816;
constexpr float EPS = 1e-6f;
constexpr float LOG2E = 1.4426950408889634f;

constexpr size_t O_YP = 0, O_YS = 8388608, O_STATE = 41943040, O_DK = 46137344, O_DV = 54525952, O_CKV = 62914560, O_KR = 71303168;

constexpr size_t OFF_MOD = 0, OFF_SCAL = 884736, OFF_CNT = 884736 + 1024, OFF_BAR = 884736 + 2048;
constexpr size_t OFF_ROPE64 = 1ull << 20, OFF_ROPE32 = 2ull << 20;
constexpr size_t OFF_WIN = 3145728, OFF_WUQ = 9437184, OFF_WUKV = 10616832, OFF_WOUT = 11141120, OFF_WGU = 13238272, OFF_WDOWN = 24772608;
constexpr size_t OFF_H = 31457280, OFF_QKV = 115343360, OFF_CQ = 262144000, OFF_CKV = 325058560, OFF_KR = 347078656;
constexpr size_t OFF_MQ = 349831168, OFF_KV = 412745728, OFF_DKC = 522846208, OFF_DVC = 523894784, WS_END = 524943360;
constexpr size_t OFF_ACT = OFF_QKV;
constexpr size_t OFF_SSQ = 2621440;
constexpr size_t OFF_U = OFF_H;
constexpr size_t OFF_MIX = OFF_CQ;

constexpr int LDS_CTL = 135168;
constexpr int LDS_BYTES = LDS_CTL + 64;

struct Params {
  const float *x_prompt, *x_sample, *c, *state_ret, *cache_dk, *cache_dv, *cache_ckv, *cache_kr, *c_ctx, *w_mod, *b_mod, *norm1, *norm2, *w_in,
      *ret_decay, *ret_gn, *diff_qk_gain, *diff_lambda, *diff_subln, *mla_q_norm, *mla_kv_norm, *w_uq, *w_ukv, *mla_qk_gain, *w_out, *w_gu, *w_down;
  float* out;
  unsigned char* ws;
  long long ph_lo, ph_hi;
};

DI int otid() { int t = threadIdx.x; asm volatile("" : "+v"(t)); return t; }
DI int ogsz() { int g = gridDim.x * 512; asm volatile("" : "+s"(g)); return g; }
DI unsigned pk2(float a, float b) { bf16v2 v; v.x = (__bf16)a; v.y = (__bf16)b; return __builtin_bit_cast(unsigned, v); }
DI float bflo(unsigned u) { return __uint_as_float(u << 16); }
DI float bfhi(unsigned u) { return __uint_as_float(u & 0xffff0000u); }
DI float bf2f(bf16_t b) { return __uint_as_float(((unsigned)b) << 16); }
DI float sx(float v, int m) { const int l = otid() & 63; return __int_as_float(__builtin_amdgcn_ds_bpermute((l ^ m) << 2, __float_as_int(v))); }
DI float wave_sum(float v) {
#pragma unroll
  for (int m = 32; m >= 1; m >>= 1) v += sx(v, m);
  return v;
}
DI float fast_exp2(float x) { return __builtin_amdgcn_exp2f(x); }
#define MFMA32(a, b, c) __builtin_amdgcn_mfma_f32_32x32x16_bf16((a), (b), (c), 0, 0, 0)
DI int crow(int i, int h) { return (i & 3) + 8 * (i >> 2) + 4 * h; }
DI bf16x4 tr_read(LAS unsigned char* p) { return __builtin_amdgcn_ds_read_tr16_b64_v4i16((LAS bf16x4*)p); }
DI bf16x8 cat8(bf16x4 a, bf16x4 b) { return __builtin_shufflevector(a, b, 0, 1, 2, 3, 4, 5, 6, 7); }

namespace pg8 {
constexpr int BM = 256, BK = 64, HALF = 128, HTB = HALF * BK * 2, STAGE_BYTES = 8 * HTB, NXCD = 8, WGM = 8;
DI int lds_byte(int r, int c) { const int st = (r >> 4) * 2 + (c >> 5), rr = r & 15, cc = c & 31, ob = rr * 64 + cc * 2; return st * 1024 + (ob ^ (((ob >> 9) & 1) << 5)); }
DI void stage_rc(int b, int& R, int& C) { const int st = b / 1024, sb = b % 1024, swz = sb ^ (((sb >> 9) & 1) << 5); R = (st >> 1) * 16 + swz / 64; C = (st & 1) * 32 + (swz % 64) / 2; }
DI int perm32(int rho) { const int n = rho >> 4, i = rho & 15; return 8 * (i >> 2) + 4 * n + (i & 3); }
struct Unit { int pm, pn; };
struct Gemm { const bf16_t* A; const bf16_t* Bt; int M, N, K, lda; };
struct StaticOrder {
  int nM, nN, nwg, G, c;
  DI void init(int M, int N, int G_, int c_) { nM = M / BM; nN = N / BM; nwg = nM * nN; G = G_; c = c_; }
  DI bool next(int i, Unit& u) const {
    const long L = (long)i * G + c; if (L >= nwg) return false;
    int wgid = (int)L; { const int q = nwg / NXCD, r = nwg % NXCD, xcd = wgid % NXCD, off = wgid / NXCD; wgid = (xcd < r ? xcd * (q + 1) : r * (q + 1) + (xcd - r) * q) + off; }
    const int nig = WGM * nN, gid = wgid / nig, fm = gid * WGM, gsz = (nM - fm) < WGM ? (nM - fm) : WGM;
    u.pm = fm + ((wgid % nig) % gsz); u.pn = (wgid % nig) / gsz; return true;
  }
};

template <class Epi>
DI void gemm_phase(LAS unsigned char* lds, const Gemm g, const StaticOrder& S, const Epi& E) {
  const int tid_ = otid();
  const int tid = tid_, wid = __builtin_amdgcn_readfirstlane(tid >> 6), lane = tid & 63, wr = wid >> 2, wc = wid & 3, fr = lane & 15, fq = lane >> 4;
  const int K = g.K, nt = K / BK, lda = g.lda;
  unsigned voffA[2], voffB[2];
#pragma unroll
  for (int i = 0; i < 2; ++i) { int R, C; stage_rc(tid * 16 + i * 8192, R, C); const int Rb = Epi::PERM ? ((R & ~31) + perm32(R & 31)) : R;
    voffA[i] = (unsigned)(R * lda + C) * 2u; voffB[i] = (unsigned)(Rb * K + C) * 2u; }
  const size_t kstep = (size_t)(BK * 2);
  const size_t hstepA = (size_t)HALF * lda * 2, hstepB = (size_t)HALF * K * 2;
  const size_t tstepA = 2 * hstepA, tstepB = 2 * hstepB;
  const unsigned ldsw = (unsigned)wid * 1024u;
  const int aoff = lds_byte(wr * 64 + fr, fq * 8), boff = lds_byte(wc * 32 + fr, fq * 8);
#define PG8_SA(b, h) (((b) * 2 + (h)) * HTB)
#define PG8_SB(b, h) ((4 + (b) * 2 + (h)) * HTB)
#define PG8_STAGE(bufoff, gbase, voff) do { _Pragma("unroll") for (int _i = 0; _i < 2; ++_i) \
        __builtin_amdgcn_global_load_lds((const unsigned*)((const char*)(gbase) + (voff)[_i]), (LAS unsigned*)(lds + (bufoff) + ldsw + _i * 8192), 16, 0, 0); } while (0)
#define PG8_LDA(dst, b, h) do { _Pragma("unroll") for (int m = 0; m < 4; ++m) _Pragma("unroll") for (int k = 0; k < 2; ++k) dst[m][k] = *(const LAS bf16x8*)(lds + PG8_SA(b, h) + aoff + m * 2048 + k * 1024); } while (0)
#define PG8_LDB(dst, b, h) do { _Pragma("unroll") for (int n = 0; n < 2; ++n) _Pragma("unroll") for (int k = 0; k < 2; ++k) dst[n][k] = *(const LAS bf16x8*)(lds + PG8_SB(b, h) + boff + n * 2048 + k * 1024); } while (0)
#define PG8_MMA(ai, bj, At, Bt) do { __builtin_amdgcn_s_setprio(1); _Pragma("unroll") for (int m = 0; m < 4; ++m) _Pragma("unroll") for (int n = 0; n < 2; ++n) _Pragma("unroll") for (int k = 0; k < 2; ++k) \
        acc[ai][bj][m][n] = __builtin_amdgcn_mfma_f32_16x16x32_bf16(Bt[n][k], At[m][k], acc[ai][bj][m][n], 0, 0, 0); __builtin_amdgcn_s_setprio(0); } while (0)
#define PG8_WAIT_V(n) asm volatile("s_waitcnt vmcnt(" #n ")" ::: "memory")
#define PG8_WAIT_L(n) asm volatile("s_waitcnt lgkmcnt(" #n ")" ::: "memory")
#define PG8_BAR __builtin_amdgcn_s_barrier()
#define PG8_SCHED __builtin_amdgcn_sched_barrier(0)
  Unit cur, nxt; int ui = 0;
  if (!S.next(0, cur)) return;
  f32x4 acc[2][2][4][2];
#pragma unroll
  for (int a = 0; a < 2; ++a)
#pragma unroll
    for (int b = 0; b < 2; ++b)
#pragma unroll
      for (int m = 0; m < 4; ++m)
#pragma unroll
        for (int n = 0; n < 2; ++n) acc[a][b][m][n] = (f32x4){0.f, 0.f, 0.f, 0.f};
  bf16x8 At[4][2], B0[2][2], B1[2][2];
  const char* cA = (const char*)g.A + (size_t)cur.pm * tstepA; const char* cB = (const char*)g.Bt + (size_t)cur.pn * tstepB;
  PG8_STAGE(PG8_SB(0, 0), cB, voffB); PG8_STAGE(PG8_SA(0, 0), cA, voffA); PG8_STAGE(PG8_SB(0, 1), cB + hstepB, voffB); PG8_STAGE(PG8_SA(0, 1), cA + hstepA, voffA);
  if (wr == 1) PG8_BAR;
  PG8_WAIT_V(4); PG8_BAR;
  PG8_STAGE(PG8_SB(1, 0), cB + kstep, voffB); PG8_STAGE(PG8_SA(1, 0), cA + kstep, voffA); PG8_STAGE(PG8_SB(1, 1), cB + hstepB + kstep, voffB);
  PG8_WAIT_V(6); PG8_BAR;
  for (;;) {
    const bool has_next = S.next(ui + 1, nxt);
    const char* nA = has_next ? (const char*)g.A + (size_t)nxt.pm * tstepA : cA; const char* nB = has_next ? (const char*)g.Bt + (size_t)nxt.pn * tstepB : cB;
    for (int t = 0; t < nt; t += 2) {
      const bool last = (t == nt - 2);
      const char* a1 = cA + (size_t)(t + 1) * kstep;
      const char* a2 = last ? nA : cA + (size_t)(t + 2) * kstep; const char* b2 = last ? nB : cB + (size_t)(t + 2) * kstep;
      const char* a3 = a2 + kstep; const char* b3 = b2 + kstep;
      PG8_LDB(B0, 0, 0); PG8_SCHED; PG8_LDA(At, 0, 0); PG8_STAGE(PG8_SA(1, 1), a1 + hstepA, voffA);
      PG8_WAIT_L(8); PG8_BAR; PG8_WAIT_L(0); PG8_MMA(0, 0, At, B0); PG8_BAR; PG8_SCHED;
      PG8_LDB(B1, 0, 1); PG8_STAGE(PG8_SB(0, 0), b2, voffB);
      PG8_BAR; PG8_WAIT_L(0); PG8_MMA(0, 1, At, B1); PG8_BAR;
      PG8_LDA(At, 0, 1); PG8_STAGE(PG8_SA(0, 0), a2, voffA);
      PG8_BAR; PG8_WAIT_L(0); PG8_MMA(1, 0, At, B0); PG8_BAR; PG8_SCHED;
      PG8_STAGE(PG8_SB(0, 1), b2 + hstepB, voffB);
      PG8_WAIT_V(6); PG8_BAR; PG8_MMA(1, 1, At, B1); PG8_BAR;
      PG8_LDB(B0, 1, 0); PG8_SCHED; PG8_LDA(At, 1, 0); PG8_STAGE(PG8_SA(0, 1), a2 + hstepA, voffA);
      PG8_WAIT_L(8); PG8_BAR; PG8_WAIT_L(0); PG8_MMA(0, 0, At, B0); PG8_BAR; PG8_SCHED;
      PG8_LDB(B1, 1, 1); PG8_STAGE(PG8_SB(1, 0), b3, voffB);
      PG8_BAR; PG8_WAIT_L(0); PG8_MMA(0, 1, At, B1); PG8_BAR;
      PG8_LDA(At, 1, 1); PG8_STAGE(PG8_SA(1, 0), a3, voffA);
      PG8_BAR; PG8_WAIT_L(0); PG8_MMA(1, 0, At, B0); PG8_BAR; PG8_SCHED;
      PG8_STAGE(PG8_SB(1, 1), b3 + hstepB, voffB);
      PG8_WAIT_V(6); PG8_BAR; PG8_MMA(1, 1, At, B1); PG8_BAR;
    }
    E(acc, cur, wr, wc, fr, fq);
    if (!has_next) break;
#pragma unroll
    for (int a = 0; a < 2; ++a)
#pragma unroll
      for (int b = 0; b < 2; ++b)
#pragma unroll
        for (int m = 0; m < 4; ++m)
#pragma unroll
          for (int n = 0; n < 2; ++n) acc[a][b][m][n] = (f32x4){0.f, 0.f, 0.f, 0.f};
    cur = nxt; cA = nA; cB = nB; ++ui;
  }
  PG8_WAIT_V(0);
  if (wr == 0) PG8_BAR;
  PG8_BAR;
#undef PG8_SA
#undef PG8_SB
#undef PG8_STAGE
#undef PG8_LDA
#undef PG8_LDB
#undef PG8_MMA
#undef PG8_WAIT_V
#undef PG8_WAIT_L
#undef PG8_BAR
#undef PG8_SCHED
}
}
using pg8::Unit;

struct EpiIn {
  static constexpr bool PERM = true;
  bf16_t *qkv, *cq, *ckv, *kr; float* ssq;
  DI void operator()(const f32x4 (&acc)[2][2][4][2], const Unit& u, int wr, int wc, int fr, int fq) const {
    const int row0 = u.pm * 256 + wr * 64 + fr; const int colt = u.pn * 256 + wc * 32 + 8 * fq;
    bf16_t* base; int ld, c0; bool okhi = true;
    if (u.pn < 7) { base = qkv; ld = LQKV; c0 = colt; }
    else if (u.pn < 10) { base = cq; ld = LCQ; c0 = colt - 1792; }
    else if (u.pn == 10) { base = ckv; ld = LCKV; c0 = colt - 2560; }
    else { base = kr; ld = LKR; c0 = colt - 2816; okhi = false; }
    const bool iscq = u.pn >= 7 && u.pn < 10;
#pragma unroll
    for (int ai = 0; ai < 2; ++ai)
#pragma unroll
      for (int m = 0; m < 4; ++m) { bf16_t* rowp = base + (size_t)(row0 + ai * 128 + m * 16) * ld + c0;
        float sq = 0.f;
#pragma unroll
        for (int bj = 0; bj < 2; ++bj) { const f32x4 v0 = acc[ai][bj][m][0], v1 = acc[ai][bj][m][1];
          if (iscq) sq += v0[0] * v0[0] + v0[1] * v0[1] + v0[2] * v0[2] + v0[3] * v0[3] + v1[0] * v1[0] + v1[1] * v1[1] + v1[2] * v1[2] + v1[3] * v1[3];
          u32x4 w; w.x = pk2(v0[0], v0[1]); w.y = pk2(v0[2], v0[3]); w.z = pk2(v1[0], v1[1]); w.w = pk2(v1[2], v1[3]);
          if (okhi || (bj == 0 && c0 < 32)) *(u32x4*)(rowp + bj * 128) = w; }
        if (iscq) { sq += sx(sq, 16); sq += sx(sq, 32); if (fq == 0) unsafeAtomicAdd(ssq + row0 + ai * 128 + m * 16, sq); } }
  }
};
struct EpiPlain {
  static constexpr bool PERM = true;
  bf16_t* O; int ld;
  DI void operator()(const f32x4 (&acc)[2][2][4][2], const Unit& u, int wr, int wc, int fr, int fq) const {
    const int row0 = u.pm * 256 + wr * 64 + fr; const int c0 = u.pn * 256 + wc * 32 + 8 * fq;
#pragma unroll
    for (int ai = 0; ai < 2; ++ai)
#pragma unroll
      for (int m = 0; m < 4; ++m) { bf16_t* rowp = O + (size_t)(row0 + ai * 128 + m * 16) * ld + c0;
#pragma unroll
        for (int bj = 0; bj < 2; ++bj) { const f32x4 v0 = acc[ai][bj][m][0], v1 = acc[ai][bj][m][1];
          u32x4 w; w.x = pk2(v0[0], v0[1]); w.y = pk2(v0[2], v0[3]); w.z = pk2(v1[0], v1[1]); w.w = pk2(v1[2], v1[3]);
          *(u32x4*)(rowp + bj * 128) = w; } }
  }
};
struct EpiKV {
  static constexpr bool PERM = true;
  bf16_t* O;
  DI void operator()(const f32x4 (&acc)[2][2][4][2], const Unit& u, int wr, int wc, int fr, int fq) const {
    const int row0 = u.pm * 256 + wr * 64 + fr;
#pragma unroll
    for (int ai = 0; ai < 2; ++ai)
#pragma unroll
      for (int m = 0; m < 4; ++m) { bf16_t* rowp = O + (size_t)(row0 + ai * 128 + m * 16) * LKV;
#pragma unroll
        for (int bj = 0; bj < 2; ++bj) { const f32x4 v0 = acc[ai][bj][m][0], v1 = acc[ai][bj][m][1];
          const int head = u.pn * 2 + bj, w128 = wc * 32 + 8 * fq; const int dst = head * 160 + (w128 < 64 ? w128 : w128 + 32);
          u32x4 w; w.x = pk2(v0[0], v0[1]); w.y = pk2(v0[2], v0[3]); w.z = pk2(v1[0], v1[1]); w.w = pk2(v1[2], v1[3]);
          *(u32x4*)(rowp + dst) = w; } }
  }
};
struct EpiRes {
  static constexpr bool PERM = false;
  float* X; const float* modl; int goff;
  const float* Xp; const float* Xs;
  DI void operator()(const f32x4 (&acc)[2][2][4][2], const Unit& u, int wr, int wc, int fr, int fq) const {
    const int rowt = u.pm * 256; const int mrow = rowt < NCTX ? 8 : ((rowt - NCTX) >> 12);
    const int row0 = rowt + wr * 64 + fr, col0 = u.pn * 256 + wc * 32 + 4 * fq;
    const float* gp = modl + mrow * 6144 + goff + col0;
    f32x4 gv[2][2];
#pragma unroll
    for (int bj = 0; bj < 2; ++bj)
#pragma unroll
      for (int n = 0; n < 2; ++n) gv[bj][n] = *(const f32x4*)(gp + bj * 128 + n * 16);
    const float* xin = Xp ? (rowt < NCTX ? Xp : Xs - (size_t)NCTX * D) : X;
    f32x4 xa[2][2][2], xb[2][2][2];
    auto qload = [&](int q, f32x4 (&xv)[2][2][2]) {
#pragma unroll
      for (int mm = 0; mm < 2; ++mm) { const float* rowp = xin + (size_t)(row0 + (q >> 1) * 128 + ((q & 1) * 2 + mm) * 16) * D + col0;
#pragma unroll
        for (int bj = 0; bj < 2; ++bj)
#pragma unroll
          for (int n = 0; n < 2; ++n) xv[mm][bj][n] = *(const f32x4*)(rowp + bj * 128 + n * 16); } };
    auto qstore = [&](int q, const f32x4 (&xv)[2][2][2]) {
#pragma unroll
      for (int mm = 0; mm < 2; ++mm) { float* rowp = X + (size_t)(row0 + (q >> 1) * 128 + ((q & 1) * 2 + mm) * 16) * D + col0;
#pragma unroll
        for (int bj = 0; bj < 2; ++bj)
#pragma unroll
          for (int n = 0; n < 2; ++n) *(f32x4*)(rowp + bj * 128 + n * 16) = xv[mm][bj][n] + gv[bj][n] * acc[q >> 1][bj][(q & 1) * 2 + mm][n]; } };
    qload(0, xa); qload(1, xb);
    qstore(0, xa); qload(2, xa);
    qstore(1, xb); qload(3, xb);
    qstore(2, xa); qstore(3, xb);
  }
};
struct EpiGU {
  static constexpr bool PERM = true;
  bf16_t* act;
  DI void operator()(const f32x4 (&acc)[2][2][4][2], const Unit& u, int wr, int wc, int fr, int fq) const {
    const int row0 = u.pm * 256 + wr * 64 + fr; const int ch0 = u.pn * 128 + wc * 32 + 8 * fq;
#pragma unroll
    for (int ai = 0; ai < 2; ++ai)
#pragma unroll
      for (int m = 0; m < 4; ++m) { bf16_t* rowp = act + (size_t)(row0 + ai * 128 + m * 16) * DFF + ch0; float r[8];
#pragma unroll
        for (int n = 0; n < 2; ++n) { const f32x4 g = acc[ai][0][m][n], uu = acc[ai][1][m][n];
#pragma unroll
          for (int j = 0; j < 4; ++j) { const float s = g[j] * __builtin_amdgcn_rcpf(1.0f + __expf(-g[j])); r[4 * n + j] = s * uu[j]; } }
        u32x4 w; w.x = pk2(r[0], r[1]); w.y = pk2(r[2], r[3]); w.z = pk2(r[4], r[5]); w.w = pk2(r[6], r[7]); *(u32x4*)rowp = w; }
  }
};

DI void phase0(const Params& p, LAS unsigned char* lds) {
  const int tid = otid(); const int gtid = blockIdx.x * 512 + tid, gsz = ogsz();
  float2* r64 = (float2*)(p.ws + OFF_ROPE64); float2* r32 = (float2*)(p.ws + OFF_ROPE32);
  for (int i = gtid; i < 4096 * 32; i += gsz) { const int t = i >> 5, j = i & 31; const float pos = (j < 16) ? (float)(t >> 6) : (float)(t & 63);
    const float inv = 1.0f / powf(10000.0f, (float)(j & 15) / 16.0f); const float a = pos * inv; r64[i] = make_float2(cosf(a), sinf(a)); }
  for (int i = gtid; i < 4096 * 16; i += gsz) { const int t = i >> 4, j = i & 15; const float pos = (j < 8) ? (float)(t >> 6) : (float)(t & 63);
    const float inv = 1.0f / powf(10000.0f, (float)(j & 7) / 8.0f); const float a = pos * inv; r32[i] = make_float2(cosf(a), sinf(a)); }
  if (blockIdx.x == 0 && tid < 4) {
    const int l = tid; float* sc = (float*)(p.ws + OFF_SCAL) + l * 16;
    const float lam_init = 0.8f - 0.6f * expf(-0.3f * (float)l);
    const float* dl = p.diff_lambda + l * 128; float s1 = 0.f, s2 = 0.f;
    for (int i = 0; i < 32; ++i) { s1 += dl[i] * dl[32 + i]; s2 += dl[64 + i] * dl[96 + i]; }
    sc[0] = expf(s1) - expf(s2) + lam_init; sc[1] = lam_init;
    float mq = 0.f, mk = 0.f; for (int i = 0; i < 32; ++i) { mq = fmaxf(mq, fabsf(p.diff_qk_gain[l * 64 + i])); mk = fmaxf(mk, fabsf(p.diff_qk_gain[l * 64 + 32 + i])); }
    sc[2] = sqrtf(32.0f) * mq * mk * LOG2E;
    mq = 0.f; mk = 0.f; for (int i = 0; i < 96; ++i) { mq = fmaxf(mq, fabsf(p.mla_qk_gain[l * 192 + i])); mk = fmaxf(mk, fabsf(p.mla_qk_gain[l * 192 + 96 + i])); }
    sc[3] = sqrtf(96.0f) * mq * mk * LOG2E;
    for (int h = 0; h < 4; ++h) { const float xf = p.ret_decay[l * 8 + h], xb = p.ret_decay[l * 8 + 4 + h];
      sc[4 + h] = -log1pf(expf(-xf)) * LOG2E; sc[8 + h] = -log1pf(expf(-xb)) * LOG2E; }
  }
  LAS float* sl = (LAS float*)lds; LAS float* red = (LAS float*)(lds + 36864);
  for (int i = tid; i < 9 * 1024; i += 512) { const int r = i >> 10, k = i & 1023; const float v = (r < 8) ? p.c[r * 1024 + k] : p.c_ctx[k]; sl[i] = v / (1.0f + __expf(-v)); }
  __syncthreads();
  const int kg = tid >> 5, cl = tid & 31;
  for (int slab = blockIdx.x; slab < 256; slab += gridDim.x) {
    const int l = slab >> 6, c0 = (slab & 63) * 96;
    const float* W = p.w_mod + (size_t)l * 1024 * 6144 + c0 + cl;
    float acc[9][3];
#pragma unroll
    for (int r = 0; r < 9; ++r) { acc[r][0] = 0.f; acc[r][1] = 0.f; acc[r][2] = 0.f; }
#pragma unroll 8
    for (int k = kg; k < 1024; k += 16) {
      const float w0 = W[(size_t)k * 6144], w1 = W[(size_t)k * 6144 + 32], w2 = W[(size_t)k * 6144 + 64];
#pragma unroll
      for (int r = 0; r < 9; ++r) { const float s = sl[r * 1024 + k]; acc[r][0] += s * w0; acc[r][1] += s * w1; acc[r][2] += s * w2; }
    }
#pragma unroll
    for (int r = 0; r < 9; ++r) { red[(kg * 9 + r) * 96 + cl] = acc[r][0]; red[(kg * 9 + r) * 96 + 32 + cl] = acc[r][1]; red[(kg * 9 + r) * 96 + 64 + cl] = acc[r][2]; }
    __syncthreads();
    for (int o = tid; o < 864; o += 512) { const int r = o / 96, cc = o % 96; float s = p.b_mod[l * 6144 + c0 + cc];
      for (int g = 0; g < 16; ++g) s += red[(g * 9 + r) * 96 + cc];
      ((float*)(p.ws + OFF_MOD))[(size_t)(l * 9 + r) * 6144 + c0 + cc] = s; }
    __syncthreads();
  }
}

DI void convert_weight_tile(const float* src, int K, int N, int nT, int tl, bf16_t* dst, int mode, LAS float* tile, const float* kgain = nullptr) {
  const int tid = otid(); const int nt = tl % nT, kt = tl / nT;
#pragma unroll
  for (int pass = 0; pass < 2; ++pass) { const int rr = pass * 32 + (tid >> 4), c4 = (tid & 15) * 4, n = nt * 64 + c4;
    f32x4 v = (f32x4){0.f, 0.f, 0.f, 0.f}; if (n < N) v = *(const f32x4*)(src + (size_t)(kt * 64 + rr) * N + n);
    tile[rr * 65 + c4] = v[0]; tile[rr * 65 + c4 + 1] = v[1]; tile[rr * 65 + c4 + 2] = v[2]; tile[rr * 65 + c4 + 3] = v[3]; }
  __syncthreads();
  { const int nn = tid >> 3, kk = (tid & 7) * 8; float v[8];
#pragma unroll
    for (int e = 0; e < 8; ++e) v[e] = tile[(kk + e) * 65 + nn];
    if (kgain) { const f32x4 g0 = *(const f32x4*)(kgain + kt * 64 + kk), g1 = *(const f32x4*)(kgain + kt * 64 + kk + 4);
#pragma unroll
      for (int e = 0; e < 4; ++e) { v[e] *= g0[e]; v[4 + e] *= g1[e]; } }
    const int n = nt * 64 + nn; int drow = n;
    if (mode == 1) { if (n < DFF) drow = 256 * (n >> 7) + (n & 127); else { const int c = n - DFF; drow = 256 * (c >> 7) + 128 + (c & 127); } }
    u32x4 w; w.x = pk2(v[0], v[1]); w.y = pk2(v[2], v[3]); w.z = pk2(v[4], v[5]); w.w = pk2(v[6], v[7]);
    *(u32x4*)(dst + (size_t)drow * K + kt * 64 + kk) = w; }
  __syncthreads();
}

DI void phase_norm(const Params& p, int l, int which, LAS unsigned char* lds) {
  const int tid = otid(), lane = tid & 63, wid = tid >> 6;
  const float* modl = (const float*)(p.ws + OFF_MOD) + (size_t)l * 9 * 6144;
  const float* gain = (which ? p.norm2 : p.norm1) + l * 1024;
  bf16_t* H = (bf16_t*)(p.ws + OFF_H);
  const bool first = (l == 0 && which == 0);
  int rstride = gridDim.x * 8; asm volatile("" : "+s"(rstride));
  f32x4 gn[4];
#pragma unroll
  for (int j = 0; j < 4; ++j) gn[j] = *(const f32x4*)(gain + j * 256 + lane * 4);
  for (int r0 = blockIdx.x * 8 + wid; r0 < NTOK; r0 += 2 * rstride) {
    f32x4 x[2][4], s1v[2][4], s0v[2][4]; const bool two = r0 + rstride < NTOK;
#pragma unroll
    for (int k = 0; k < 2; ++k) { const int r = r0 + k * rstride; if (k == 0 || two) {
      const float* src = first ? (r < NCTX ? p.x_prompt + (size_t)r * D : p.x_sample + (size_t)(r - NCTX) * D) : p.out + (size_t)r * D;
      const int mrow = r < NCTX ? 8 : ((r - NCTX) >> 12);
      const float* sh = modl + mrow * 6144 + (which ? 3072 : 0); const float* scl = sh + 1024;
#pragma unroll
      for (int j = 0; j < 4; ++j) { x[k][j] = *(const f32x4*)(src + j * 256 + lane * 4); s1v[k][j] = *(const f32x4*)(scl + j * 256 + lane * 4); s0v[k][j] = *(const f32x4*)(sh + j * 256 + lane * 4); } } }
#pragma unroll
    for (int k = 0; k < 2; ++k) { const int r = r0 + k * rstride; if (k == 0 || two) {
      float ss = 0.f;
#pragma unroll
      for (int j = 0; j < 4; ++j) ss += x[k][j][0] * x[k][j][0] + x[k][j][1] * x[k][j][1] + x[k][j][2] * x[k][j][2] + x[k][j][3] * x[k][j][3];
      ss = wave_sum(ss); const float rstd = rsqrtf(ss * (1.0f / 1024.0f) + EPS);
#pragma unroll
      for (int j = 0; j < 4; ++j) { const int c = j * 256 + lane * 4;
        f32x4 y = x[k][j] * rstd * gn[j]; y = y * (s1v[k][j] + 1.0f) + s0v[k][j];
        u32x2 w; w.x = pk2(y[0], y[1]); w.y = pk2(y[2], y[3]); *(u32x2*)(H + (size_t)r * D + c) = w;
        } } }
  }
  if (which) return;
  LAS float* tile = (LAS float*)lds;
  for (int t = blockIdx.x; t < 3344; t += gridDim.x) {
    if (t < 768) convert_weight_tile(p.w_in + (size_t)l * 1024 * 2848, 1024, 2848, 48, t, (bf16_t*)(p.ws + OFF_WIN), 0, tile);
    else if (t < 912) convert_weight_tile(p.w_uq + (size_t)l * 768 * 768, 768, 768, 12, t - 768, (bf16_t*)(p.ws + OFF_WUQ), 0, tile, p.mla_q_norm + l * 768);
    else if (t < 976) convert_weight_tile(p.w_ukv + (size_t)l * 256 * 1024, 256, 1024, 16, t - 912, (bf16_t*)(p.ws + OFF_WUKV), 0, tile);
    else if (t < 1232) convert_weight_tile(p.w_out + (size_t)l * 1024 * 1024, 1024, 1024, 16, t - 976, (bf16_t*)(p.ws + OFF_WOUT), 0, tile);
    else if (t < 2640) convert_weight_tile(p.w_gu + (size_t)l * 1024 * 5632, 1024, 5632, 88, t - 1232, (bf16_t*)(p.ws + OFF_WGU), 1, tile);
    else convert_weight_tile(p.w_down + (size_t)l * 2816 * 1024, 2816, 1024, 16, t - 2640, (bf16_t*)(p.ws + OFF_WDOWN), 0, tile);
  }
  { float* z = (float*)(p.ws + OFF_SSQ); const int zs = ogsz(); float zf = 0.f; asm volatile("" : "+v"(zf));
#pragma clang loop vectorize(disable)
    for (int i = blockIdx.x * 512 + tid; i < NTOK; i += zs) z[i] = zf; }
  const int gtid = blockIdx.x * 512 + tid, gsz = ogsz();
  bf16_t* CKV = (bf16_t*)(p.ws + OFF_CKV); bf16_t* KR = (bf16_t*)(p.ws + OFF_KR); bf16_t* DKC = (bf16_t*)(p.ws + OFF_DKC); bf16_t* DVC = (bf16_t*)(p.ws + OFF_DVC);
  for (int i = gtid; i < NCACHE * 256; i += gsz) { const int row = i >> 8, col = i & 255, b = row >> 8, t = row & 255; const size_t s = ((size_t)(b * 4 + l) * 256 + t) * 256 + col;
    CKV[(size_t)(NTOK + row) * 256 + col] = (bf16_t)(pk2(p.cache_ckv[s], 0.f) & 0xffff);
    DKC[i] = (bf16_t)(pk2(p.cache_dk[s], 0.f) & 0xffff); DVC[i] = (bf16_t)(pk2(p.cache_dv[s], 0.f) & 0xffff); }
  for (int i = gtid; i < NCACHE * 32; i += gsz) { const int row = i >> 5, col = i & 31, b = row >> 8, t = row & 255;
    KR[(size_t)(NTOK + row) * 32 + col] = (bf16_t)(pk2(p.cache_kr[((size_t)(b * 4 + l) * 256 + t) * 32 + col], 0.f) & 0xffff); }
}

DI void phase_post1(const Params& p, int l) {
  const int tid = otid(), lane = tid & 63, wid = tid >> 6;
  bf16_t* QKV = (bf16_t*)(p.ws + OFF_QKV); bf16_t* CQ = (bf16_t*)(p.ws + OFF_CQ); bf16_t* CKV = (bf16_t*)(p.ws + OFF_CKV); const bf16_t* KR = (const bf16_t*)(p.ws + OFF_KR);
  const float2* r64 = (const float2*)(p.ws + OFF_ROPE64); const float2* r32 = (const float2*)(p.ws + OFF_ROPE32);
  const float qscale_d = 0.17677669529663687f * LOG2E;
  struct Raw { u32x2 ra, rb, da, db, dv, cq[3], ck; float kr; f32x4 t64[2], t32[2]; };
  f32x4 gd1, gd2, gqn[3], gkv;
  { const float* g = p.diff_qk_gain + l * 64 + ((lane >> 2) >= 8 ? 32 : 0); gd1 = *(const f32x4*)(g + 4 * (lane & 3)); gd2 = *(const f32x4*)(g + 16 + 4 * (lane & 3));
#pragma unroll
    for (int j = 0; j < 3; ++j) gqn[j] = *(const f32x4*)(p.mla_q_norm + l * 768 + j * 256 + lane * 4);
    gkv = *(const f32x4*)(p.mla_kv_norm + l * 256 + lane * 4); }
  auto load_row = [&](int r, Raw& w) {
    const bf16_t* q = QKV + (size_t)r * LQKV;
    { const bf16_t* base = q + (lane >> 3) * 64 + 4 * (lane & 7); w.ra = *(const u32x2*)base; w.rb = *(const u32x2*)(base + 32); }
    if ((lane >> 2) >= 8) { const bf16_t* base = q + 1024 + (lane >> 2) * 32 + 4 * (lane & 3); w.da = *(const u32x2*)base; w.db = *(const u32x2*)(base + 16); }
    if (r < NCTX) w.dv = *(const u32x2*)(q + 1536 + lane * 4);
    w.ck = *(const u32x2*)(CKV + (size_t)r * LCKV + lane * 4);
    w.kr = bf2f(KR[(size_t)r * LKR + (lane & 31)]);
    if (r >= NCTX) { const int t = (r - NCTX) & 4095; const f32x4* a = (const f32x4*)(r64 + t * 32 + 4 * (lane & 7)); w.t64[0] = a[0]; w.t64[1] = a[1];
      const f32x4* bq = (const f32x4*)(r32 + t * 16 + 4 * (lane & 3)); w.t32[0] = bq[0]; w.t32[1] = bq[1]; }
  };
  auto finish_row = [&](int r, const Raw& w) {
    const bool lat = r >= NCTX; const int t = lat ? ((r - NCTX) & 4095) : (r & 255); const int b = r >> 8;
    const size_t obase = ((size_t)(b * 4 + l) * 256 + t);
    bf16_t* q = QKV + (size_t)r * LQKV;
    {
      const int hh = lane >> 3, sub = lane & 7; bf16_t* base = q + hh * 64 + 4 * sub;
      const u32x2 a = w.ra, bb = w.rb;
      float x1[4] = {bflo(a.x), bfhi(a.x), bflo(a.y), bfhi(a.y)}, x2[4] = {bflo(bb.x), bfhi(bb.x), bflo(bb.y), bfhi(bb.y)};
      const float sc = hh >= 4 ? 0.125f : 1.0f;
      if (lat) {
#pragma unroll
        for (int e = 0; e < 4; ++e) { const float cx = w.t64[e >> 1][2 * (e & 1)], cy = w.t64[e >> 1][2 * (e & 1) + 1]; const float o1 = x1[e] * cx - x2[e] * cy, o2 = x2[e] * cx + x1[e] * cy; x1[e] = o1; x2[e] = o2; }
      }
      u32x2 w1, w2; w1.x = pk2(x1[0] * sc, x1[1] * sc); w1.y = pk2(x1[2] * sc, x1[3] * sc); w2.x = pk2(x2[0] * sc, x2[1] * sc); w2.y = pk2(x2[2] * sc, x2[3] * sc);
      *(u32x2*)base = w1; *(u32x2*)(base + 32) = w2;
    }
    if ((lane >> 2) >= 8) {
      const int grp = lane >> 2, sub = lane & 3; bf16_t* base = q + 1024 + grp * 32 + 4 * sub;
      const u32x2 a = w.da, bb = w.db;
      float x1[4] = {bflo(a.x), bfhi(a.x), bflo(a.y), bfhi(a.y)}, x2[4] = {bflo(bb.x), bfhi(bb.x), bflo(bb.y), bfhi(bb.y)};
      float ss = 0.f;
#pragma unroll
      for (int e = 0; e < 4; ++e) ss += x1[e] * x1[e] + x2[e] * x2[e];
      ss += sx(ss, 1); ss += sx(ss, 2);
      const float rstd = rsqrtf(ss * (1.0f / 32.0f) + EPS);
#pragma unroll
      for (int e = 0; e < 4; ++e) { x1[e] = x1[e] * rstd * gd1[e]; x2[e] = x2[e] * rstd * gd2[e]; }
      if (!lat && grp >= 8) { float* o = p.out + O_DK + obase * 256 + (grp - 8) * 32 + 4 * sub;
        *(f32x4*)o = (f32x4){x1[0], x1[1], x1[2], x1[3]}; *(f32x4*)(o + 16) = (f32x4){x2[0], x2[1], x2[2], x2[3]}; }
      if (lat) {
#pragma unroll
        for (int e = 0; e < 4; ++e) { const float cx = w.t32[e >> 1][2 * (e & 1)], cy = w.t32[e >> 1][2 * (e & 1) + 1]; const float o1 = x1[e] * cx - x2[e] * cy, o2 = x2[e] * cx + x1[e] * cy; x1[e] = o1; x2[e] = o2; }
      }
      const float sc = grp < 8 ? qscale_d : 1.0f;
      u32x2 w1, w2; w1.x = pk2(x1[0] * sc, x1[1] * sc); w1.y = pk2(x1[2] * sc, x1[3] * sc); w2.x = pk2(x2[0] * sc, x2[1] * sc); w2.y = pk2(x2[2] * sc, x2[3] * sc);
      *(u32x2*)base = w1; *(u32x2*)(base + 16) = w2;
    }
    if (!lat) {
      const u32x2 a = w.dv;
      *(f32x4*)(p.out + O_DV + obase * 256 + lane * 4) = (f32x4){bflo(a.x), bfhi(a.x), bflo(a.y), bfhi(a.y)};
    }
    {
      bf16_t* ck = CKV + (size_t)r * LCKV + lane * 4; const u32x2 a = w.ck; float x[4] = {bflo(a.x), bfhi(a.x), bflo(a.y), bfhi(a.y)};
      float ss = x[0] * x[0] + x[1] * x[1] + x[2] * x[2] + x[3] * x[3]; ss = wave_sum(ss); const float rstd = rsqrtf(ss * (1.0f / 256.0f) + EPS);
      const f32x4 g = gkv;
      const f32x4 y = (f32x4){x[0] * rstd * g[0], x[1] * rstd * g[1], x[2] * rstd * g[2], x[3] * rstd * g[3]};
      u32x2 wv; wv.x = pk2(y[0], y[1]); wv.y = pk2(y[2], y[3]); *(u32x2*)ck = wv;
      if (!lat) *(f32x4*)(p.out + O_CKV + obase * 256 + lane * 4) = y;
    }
    if (!lat && lane < 32) p.out[O_KR + obase * 32 + lane] = w.kr;
  };
  int rstride = gridDim.x * 8; asm volatile("" : "+s"(rstride));
  for (int r0 = blockIdx.x * 8 + wid; r0 < NTOK; r0 += 3 * rstride) {
    Raw A, B, C; const bool h1 = r0 + rstride < NTOK, h2 = r0 + 2 * rstride < NTOK;
    load_row(r0, A); if (h1) load_row(r0 + rstride, B); if (h2) load_row(r0 + 2 * rstride, C);
    finish_row(r0, A); if (h1) finish_row(r0 + rstride, B); if (h2) finish_row(r0 + 2 * rstride, C);
  }
}

DI void ret_u_items(const Params& p, int l, LAS unsigned char* lds) {
  const int tid = otid(), lane = tid & 63, wid = tid >> 6, r = lane & 31, h = lane >> 5, q4 = (lane & 15) >> 2, p4 = lane & 3, g = (lane >> 4) & 1;
  const bf16_t* QKV = (const bf16_t*)(p.ws + OFF_QKV); float* U = (float*)(p.ws + OFF_U);
  const float* sc = (const float*)(p.ws + OFF_SCAL) + l * 16;
  for (int it = blockIdx.x; it < 1280; it += gridDim.x) {
    const int hd = it & 3, scn = it >> 2; int rowbase, ubase, ustride_dir;
    if (scn < 64) { const int b = scn >> 1, ch = scn & 1; rowbase = b * 256 + ch * 128; ubase = ((b * 4 + hd) * 2) * 2 + ch; ustride_dir = 2; }
    else { const int s2 = scn - 64, b = s2 >> 5, ch = s2 & 31; rowbase = NCTX + b * 4096 + ch * 128; ubase = 512 + ((b * 4 + hd) * 2) * 32 + ch; ustride_dir = 32; }
#pragma unroll
    for (int i = 0; i < 2; ++i) { const int id = tid + i * 512, row = id >> 3, cc = id & 7; const bf16_t* src = QKV + (size_t)(rowbase + row) * LQKV + hd * 64 + cc * 8;
      const u32x4 kv = *(const u32x4*)(src + 256), vv = *(const u32x4*)(src + 512);
      *(LAS u32x4*)(lds + row * 144 + cc * 16) = kv; *(LAS u32x4*)(lds + 18432 + row * 144 + cc * 16) = vv; }
    __syncthreads();
    const int dir = wid >> 2, dkt = (wid >> 1) & 1, dvt = wid & 1; const float lg = sc[4 + dir * 4 + hd];
    f32x16 acc; for (int i = 0; i < 16; ++i) acc[i] = 0.f;
#pragma unroll
    for (int s = 0; s < 8; ++s) {
      LAS unsigned char* ka = lds + (16 * s + 8 * h + q4) * 144 + (dkt * 32 + 16 * g + 4 * p4) * 2;
      LAS unsigned char* va = lds + 18432 + (16 * s + 8 * h + q4) * 144 + (dvt * 32 + 16 * g + 4 * p4) * 2;
      const bf16x8 kf = cat8(tr_read(ka), tr_read(ka + 4 * 144)); const bf16x8 vf = cat8(tr_read(va), tr_read(va + 4 * 144));
      const u32x4 ku = __builtin_bit_cast(u32x4, kf); float kx[8] = {bflo(ku.x), bfhi(ku.x), bflo(ku.y), bfhi(ku.y), bflo(ku.z), bfhi(ku.z), bflo(ku.w), bfhi(ku.w)};
#pragma unroll
      for (int j = 0; j < 8; ++j) { const int m = 16 * s + 8 * h + j; const float w = fast_exp2((dir ? (float)m : (float)(127 - m)) * lg); kx[j] *= w; }
      u32x4 kw; kw.x = pk2(kx[0], kx[1]); kw.y = pk2(kx[2], kx[3]); kw.z = pk2(kx[4], kx[5]); kw.w = pk2(kx[6], kx[7]);
      acc = MFMA32(__builtin_bit_cast(bf16x8, kw), vf, acc);
    }
    float* up = U + (size_t)(ubase + dir * ustride_dir) * 4096;
#pragma unroll
    for (int i = 0; i < 16; ++i) up[(dkt * 32 + crow(i, h)) * 64 + dvt * 32 + r] = acc[i];
    __syncthreads();
  }
}

DI void phase_post2(const Params& p, int l) {
  const int tid = otid(), lane = tid & 63, wid = tid >> 6;
  bf16_t* MQ = (bf16_t*)(p.ws + OFF_MQ); bf16_t* KV = (bf16_t*)(p.ws + OFF_KV); const bf16_t* KR = (const bf16_t*)(p.ws + OFF_KR);
  const float2* r32 = (const float2*)(p.ws + OFF_ROPE32);
  const float qscale = 0.10206207261596575f * LOG2E;
  const int hh = lane >> 3, sub = lane & 7;
  const float* gq = p.mla_qk_gain + l * 192; const float* gk = gq + 96;
  struct Raw2 { u32x4 qa; unsigned q1, q2; u32x4 ka; unsigned k1, k2; f32x4 cs; float ssq; };
  float gq8[8], gq1[2], gq2[2], gk8[8], gk1[2], gk2[2];
#pragma unroll
  for (int e = 0; e < 8; ++e) { gq8[e] = gq[8 * sub + e]; gk8[e] = gk[8 * sub + e]; }
#pragma unroll
  for (int e = 0; e < 2; ++e) { gq1[e] = gq[64 + 2 * sub + e]; gq2[e] = gq[80 + 2 * sub + e]; gk1[e] = gk[64 + 2 * sub + e]; gk2[e] = gk[80 + 2 * sub + e]; }
  auto load_row = [&](int r, Raw2& w) {
    const bf16_t* kb = KV + (size_t)r * LKV + hh * 160; w.ka = *(const u32x4*)(kb + 8 * sub);
    w.k1 = *(const unsigned*)(KR + (size_t)r * LKR + 2 * sub); w.k2 = *(const unsigned*)(KR + (size_t)r * LKR + 16 + 2 * sub);
    w.cs = (f32x4){1.f, 0.f, 1.f, 0.f}; if (r >= NCTX && r < NTOK) w.cs = *(const f32x4*)(r32 + ((r - NCTX) & 4095) * 16 + 2 * sub);
  };
  auto finish_row = [&](int r, const Raw2& w) {
    const bool lat = (r >= NCTX && r < NTOK); const int t = (r - NCTX) & 4095;
    const float2 cs[2] = {make_float2(w.cs[0], w.cs[1]), make_float2(w.cs[2], w.cs[3])}; (void)lat; (void)t;
    {
      bf16_t* base = KV + (size_t)r * LKV + hh * 160; const u32x4 a = w.ka; const unsigned b1 = w.k1, b2 = w.k2;
      float x[8] = {bflo(a.x), bfhi(a.x), bflo(a.y), bfhi(a.y), bflo(a.z), bfhi(a.z), bflo(a.w), bfhi(a.w)}; float y1[2] = {bflo(b1), bfhi(b1)}, y2[2] = {bflo(b2), bfhi(b2)};
      float ss = y1[0] * y1[0] + y1[1] * y1[1] + y2[0] * y2[0] + y2[1] * y2[1];
#pragma unroll
      for (int e = 0; e < 8; ++e) ss += x[e] * x[e];
      ss += sx(ss, 1); ss += sx(ss, 2); ss += sx(ss, 4);
      const float rstd = rsqrtf(ss * (1.0f / 96.0f) + EPS);
#pragma unroll
      for (int e = 0; e < 8; ++e) x[e] = x[e] * rstd * gk8[e];
#pragma unroll
      for (int e = 0; e < 2; ++e) { const float a1 = y1[e] * rstd * gk1[e], a2 = y2[e] * rstd * gk2[e];
        y1[e] = a1 * cs[e].x - a2 * cs[e].y; y2[e] = a2 * cs[e].x + a1 * cs[e].y; }
      u32x4 wv; wv.x = pk2(x[0], x[1]); wv.y = pk2(x[2], x[3]); wv.z = pk2(x[4], x[5]); wv.w = pk2(x[6], x[7]);
      *(u32x4*)(base + 8 * sub) = wv; *(unsigned*)(base + 64 + 2 * sub) = pk2(y1[0], y1[1]); *(unsigned*)(base + 80 + 2 * sub) = pk2(y2[0], y2[1]);
    }
  };
  int rstride = gridDim.x * 8; asm volatile("" : "+s"(rstride));
  for (int r0 = blockIdx.x * 8 + wid; r0 < NKVROWS; r0 += 6 * rstride) {
    Raw2 R[6]; bool hv[6];
#pragma unroll
    for (int k = 0; k < 6; ++k) { hv[k] = r0 + k * rstride < NKVROWS; if (hv[k]) load_row(r0 + k * rstride, R[k]); }
#pragma unroll
    for (int k = 0; k < 6; ++k) if (hv[k]) finish_row(r0 + k * rstride, R[k]);
  }
  float* U = (float*)(p.ws + OFF_U); const float* sc = (const float*)(p.ws + OFF_SCAL) + l * 16;
  const int gtid = blockIdx.x * 512 + tid, gsz = ogsz();
  for (int i = gtid; i < 262144; i += gsz) {
    const int e = i & 4095, sd = i >> 12, dir = sd & 1, bh = sd >> 1, hd = bh & 3, b = bh >> 2;
    float* up = U + (size_t)(512 + (bh * 2 + dir) * 32) * 4096 + e;
    const float gC = fast_exp2(128.0f * sc[4 + dir * 4 + hd]);
    float S = p.state_ret[((size_t)((b * 4 + l) * 2 + dir) * 4 + hd) * 4096 + e];
    float u[32];
#pragma unroll
    for (int c = 0; c < 32; ++c) u[c] = up[(size_t)c * 4096];
    if (dir == 0) {
#pragma unroll
      for (int c = 0; c < 32; ++c) { up[(size_t)c * 4096] = S; S = gC * S + u[c]; } }
    else {
#pragma unroll
      for (int c = 31; c >= 0; --c) { up[(size_t)c * 4096] = S; S = gC * S + u[c]; } }
  }
  for (int i0 = gtid; i0 < 1048576; i0 += 4 * gsz) {
    float u0[4], u1[4];
#pragma unroll
    for (int k = 0; k < 4; ++k) { const int i = i0 + k * gsz; if (i < 1048576) { const int e = i & 4095, sd = i >> 12; const float* up = U + (size_t)(sd * 2) * 4096 + e; u0[k] = up[0]; u1[k] = up[4096]; } }
#pragma unroll
    for (int k = 0; k < 4; ++k) { const int i = i0 + k * gsz; if (i < 1048576) { const int e = i & 4095, sd = i >> 12, dir = sd & 1, bh = sd >> 1, hd = bh & 3, b = bh >> 2;
      float* up = U + (size_t)(sd * 2) * 4096 + e; const float gC = fast_exp2(128.0f * sc[4 + dir * 4 + hd]); float S;
      if (dir == 0) { up[0] = 0.f; up[4096] = u0[k]; S = gC * u0[k] + u1[k]; }
      else { up[4096] = 0.f; up[0] = u1[k]; S = gC * u1[k] + u0[k]; }
      p.out[O_STATE + ((size_t)((b * 4 + l) * 2 + dir) * 4 + hd) * 4096 + e] = S; } }
  }
}

struct NoQFix { template <int NM, int NK> DI void operator()(bf16x8 (&)[NM][NK], int, int) const {} };
struct MlaQFix {
  const float* ssq; const float* gq; const float2* r32; int lat; int t0; float qscale;
  DI void operator()(bf16x8 (&q)[1][6], int qrow, int h) const {
    const float sq = ssq[qrow];
    f32x4 g[6][2];
#pragma unroll
    for (int ks = 0; ks < 6; ++ks) { g[ks][0] = *(const f32x4*)(gq + ks * 16 + 8 * h); g[ks][1] = *(const f32x4*)(gq + ks * 16 + 8 * h + 4); }
    f32x4 tb[4];
    if (lat) { const f32x4* tp = (const f32x4*)(r32 + (size_t)(t0 + qrow) * 16 + 8 * h);
#pragma unroll
      for (int i = 0; i < 4; ++i) tb[i] = tp[i]; }
    float x[6][8]; float ss = 0.f;
#pragma unroll
    for (int ks = 0; ks < 6; ++ks) { const u32x4 u = __builtin_bit_cast(u32x4, q[0][ks]);
#pragma unroll
      for (int m = 0; m < 4; ++m) { x[ks][2 * m] = bflo(u[m]); x[ks][2 * m + 1] = bfhi(u[m]); ss += x[ks][2 * m] * x[ks][2 * m] + x[ks][2 * m + 1] * x[ks][2 * m + 1]; } }
    ss += sx(ss, 32);
    const float rstd = rsqrtf(ss * (1.0f / 96.0f) + EPS * (sq * (1.0f / 768.0f) + EPS));
#pragma unroll
    for (int ks = 0; ks < 6; ++ks)
#pragma unroll
      for (int j = 0; j < 8; ++j) x[ks][j] *= rstd * g[ks][j >> 2][j & 3];
    if (lat) {
#pragma unroll
      for (int j = 0; j < 8; ++j) { const float cx = tb[j >> 1][2 * (j & 1)], cy = tb[j >> 1][2 * (j & 1) + 1]; const float a1 = x[4][j], a2 = x[5][j]; x[4][j] = a1 * cx - a2 * cy; x[5][j] = a2 * cx + a1 * cy; }
    }
#pragma unroll
    for (int ks = 0; ks < 6; ++ks) { u32x4 w;
#pragma unroll
      for (int m = 0; m < 4; ++m) w[m] = pk2(x[ks][2 * m] * qscale, x[ks][2 * m + 1] * qscale);
      q[0][ks] = __builtin_bit_cast(bf16x8, w); }
  }
};
struct DiffQFix {
  const float* gq; const float2* r32; int lat; int t0; float qscale;
  DI void operator()(bf16x8 (&q)[2][2], int qrow, int h) const {
    f32x4 g[2][2];
#pragma unroll
    for (int ks = 0; ks < 2; ++ks) { g[ks][0] = *(const f32x4*)(gq + ks * 16 + 8 * h); g[ks][1] = *(const f32x4*)(gq + ks * 16 + 8 * h + 4); }
    f32x4 tb[4];
    if (lat) { const f32x4* tp = (const f32x4*)(r32 + (size_t)(t0 + qrow) * 16 + 8 * h);
#pragma unroll
      for (int i = 0; i < 4; ++i) tb[i] = tp[i]; }
#pragma unroll
    for (int mp = 0; mp < 2; ++mp) {
      float x[2][8]; float ss = 0.f;
#pragma unroll
      for (int ks = 0; ks < 2; ++ks) { const u32x4 u = __builtin_bit_cast(u32x4, q[mp][ks]);
#pragma unroll
        for (int m = 0; m < 4; ++m) { x[ks][2 * m] = bflo(u[m]); x[ks][2 * m + 1] = bfhi(u[m]); ss += x[ks][2 * m] * x[ks][2 * m] + x[ks][2 * m + 1] * x[ks][2 * m + 1]; } }
      ss += sx(ss, 32);
      const float rstd = rsqrtf(ss * (1.0f / 32.0f) + EPS);
#pragma unroll
      for (int ks = 0; ks < 2; ++ks)
#pragma unroll
        for (int j = 0; j < 8; ++j) x[ks][j] *= rstd * g[ks][j >> 2][j & 3];
      if (lat) {
#pragma unroll
        for (int j = 0; j < 8; ++j) { const float cx = tb[j >> 1][2 * (j & 1)], cy = tb[j >> 1][2 * (j & 1) + 1]; const float a1 = x[0][j], a2 = x[1][j]; x[0][j] = a1 * cx - a2 * cy; x[1][j] = a2 * cx + a1 * cy; }
      }
#pragma unroll
      for (int ks = 0; ks < 2; ++ks) { u32x4 w;
#pragma unroll
        for (int m = 0; m < 4; ++m) w[m] = pk2(x[ks][2 * m] * qscale, x[ks][2 * m + 1] * qscale);
        q[mp][ks] = __builtin_bit_cast(bf16x8, w); }
    }
  }
};
template <int DQK, int NMAP, bool ONES, class QF>
DI void attn_item(LAS unsigned char* lds, const bf16_t* Q, int ldq,
                  const bf16_t* K0, const bf16_t* V0, int ldk0, int ldv0, int nt0,
                  const bf16_t* K1, const bf16_t* V1, int ldk1, int ldv1, int nt1,
                  float Mb2, float (&lsum)[NMAP], f32x16 (&accO)[NMAP][2], const QF& qfix) {
  constexpr int KW = NMAP * DQK, KS = KW + 8, VS = 72, CPRK = KW / 8, NK = 128 * CPRK / 512, KBYTES = 128 * KS * 2, BUFSZ = KBYTES + 128 * VS * 2, NKS = DQK / 16, NU = 4 * NMAP;
  const int tid_ = otid();
  const int tid = tid_, lane = tid & 63, wid = tid >> 6, r = lane & 31, h = lane >> 5, q4 = (lane & 15) >> 2, p4 = lane & 3, g = (lane >> 4) & 1;
  bf16x8 qreg[NMAP][NKS];
#pragma unroll
  for (int mp = 0; mp < NMAP; ++mp)
#pragma unroll
    for (int ks = 0; ks < NKS; ++ks) qreg[mp][ks] = *(const bf16x8*)(Q + (size_t)(wid * 32 + r) * ldq + mp * DQK + ks * 16 + 8 * h);
  qfix(qreg, wid * 32 + r, h);
  f32x16 accL[NMAP];
#pragma unroll
  for (int mp = 0; mp < NMAP; ++mp) { lsum[mp] = 0.f;
#pragma unroll
    for (int i = 0; i < 16; ++i) { accO[mp][0][i] = 0.f; accO[mp][1][i] = 0.f; accL[mp][i] = 0.f; } }
  const bf16x8 ones = {(short)0x3F80, (short)0x3F80, (short)0x3F80, (short)0x3F80, (short)0x3F80, (short)0x3F80, (short)0x3F80, (short)0x3F80};
  const int nt = nt0 + nt1;
  const int koff = r * (KS * 2) + 16 * h;
  const int voff = (4 * h + q4) * (VS * 2) + (16 * g + 4 * p4) * 2;
  u32x4 kst[NK], vst[2];
  auto gload = [&](int t) {
    const bf16_t* Kp; const bf16_t* Vp; int ldk, ldv;
    if (t < nt0) { Kp = K0 + (size_t)t * 128 * ldk0; Vp = V0 + (size_t)t * 128 * ldv0; ldk = ldk0; ldv = ldv0; }
    else { Kp = K1 + (size_t)(t - nt0) * 128 * ldk1; Vp = V1 + (size_t)(t - nt0) * 128 * ldv1; ldk = ldk1; ldv = ldv1; }
#pragma unroll
    for (int i = 0; i < NK; ++i) { const int id = tid + i * 512, row = id / CPRK, cc = id % CPRK; kst[i] = *(const u32x4*)(Kp + (size_t)row * ldk + cc * 8); }
#pragma unroll
    for (int i = 0; i < 2; ++i) { const int id = tid + i * 512, row = id >> 3, cc = id & 7; vst[i] = *(const u32x4*)(Vp + (size_t)row * ldv + cc * 8); }
  };
  auto lstore = [&](LAS unsigned char* kb) {
    LAS unsigned char* vb = kb + KBYTES;
#pragma unroll
    for (int i = 0; i < NK; ++i) { const int id = tid + i * 512, row = id / CPRK, cc = id % CPRK; *(LAS u32x4*)(kb + row * (KS * 2) + cc * 16) = kst[i]; }
#pragma unroll
    for (int i = 0; i < 2; ++i) { const int id = tid + i * 512, row = id >> 3, cc = id & 7; *(LAS u32x4*)(vb + row * (VS * 2) + cc * 16) = vst[i]; }
  };
  auto QK = [&](LAS unsigned char* kb, int st, int mp, f32x16& s) {
#pragma unroll
    for (int i = 0; i < 16; ++i) s[i] = -Mb2;
#pragma unroll
    for (int ks = 0; ks < NKS; ++ks) { const bf16x8 kf = *(const LAS bf16x8*)(kb + st * 32 * (KS * 2) + koff + (mp * DQK + ks * 16) * 2); s = MFMA32(kf, qreg[mp][ks], s); }
  };
  auto PV = [&](LAS unsigned char* kb, int st, int mp, const bf16x8& pb0, const bf16x8& pb1) {
    LAS unsigned char* vb = kb + KBYTES + st * 32 * (VS * 2) + voff;
#pragma unroll
    for (int dvt = 0; dvt < 2; ++dvt) {
      LAS unsigned char* va = vb + dvt * 64;
      const bf16x8 vf0 = cat8(tr_read(va), tr_read(va + 8 * VS * 2)), vf1 = cat8(tr_read(va + 16 * VS * 2), tr_read(va + 24 * VS * 2));
      accO[mp][dvt] = MFMA32(vf0, pb0, accO[mp][dvt]); accO[mp][dvt] = MFMA32(vf1, pb1, accO[mp][dvt]);
    }
    if (ONES) { accL[mp] = MFMA32(ones, pb0, accL[mp]); accL[mp] = MFMA32(ones, pb1, accL[mp]); }
  };
  auto EXPK = [&](f32x16& s, int mp, bf16x8& pb0, bf16x8& pb1) {
    float ps = 0.f;
#pragma unroll
    for (int i = 0; i < 16; ++i) { s[i] = fast_exp2(s[i]); if (!ONES) ps += s[i]; }
    if (!ONES) lsum[mp] += ps;
    u32x4 p0, p1; p0.x = pk2(s[0], s[1]); p0.y = pk2(s[2], s[3]); p0.z = pk2(s[4], s[5]); p0.w = pk2(s[6], s[7]);
    p1.x = pk2(s[8], s[9]); p1.y = pk2(s[10], s[11]); p1.z = pk2(s[12], s[13]); p1.w = pk2(s[14], s[15]);
    pb0 = __builtin_bit_cast(bf16x8, p0); pb1 = __builtin_bit_cast(bf16x8, p1);
  };
  gload(0); lstore(lds);
  if (nt > 1) gload(1);
  __syncthreads();
  f32x16 s_next, s_cur; bf16x8 pp0, pp1;
  QK(lds, 0, 0, s_next);
  int bcur = 0, bprev = 2;
  for (int t = 0; t < nt; ++t) {
    const int bnext = bcur == 2 ? 0 : bcur + 1;
    LAS unsigned char* kbc = lds + bcur * BUFSZ; LAS unsigned char* kbp = lds + bprev * BUFSZ; LAS unsigned char* kbn = lds + bnext * BUFSZ;
#pragma unroll
    for (int u = 0; u < NU; ++u) {
      if (u == NU - 1) {
        if (t + 1 < nt) { lstore(kbn); if (t + 2 < nt) gload(t + 2); }
        __syncthreads();
      }
#pragma unroll
      for (int i = 0; i < 16; ++i) s_cur[i] = s_next[i];
      if (u < NU - 1) QK(kbc, (u + 1) / NMAP, (u + 1) % NMAP, s_next);
      else if (t + 1 < nt) QK(kbn, 0, 0, s_next);
      if (u > 0) PV(kbc, (u - 1) / NMAP, (u - 1) % NMAP, pp0, pp1);
      else if (t > 0) PV(kbp, 3, NMAP - 1, pp0, pp1);
      EXPK(s_cur, u % NMAP, pp0, pp1);
    }
    bprev = bcur; bcur = bnext;
  }
  PV(lds + bprev * BUFSZ, 3, NMAP - 1, pp0, pp1);
#pragma unroll
  for (int mp = 0; mp < NMAP; ++mp) { if (ONES) lsum[mp] = accL[mp][0]; else lsum[mp] += sx(lsum[mp], 32); }
  __syncthreads();
}

DI void mla_item(const Params& p, int l, LAS unsigned char* lds, bool lat, int b, int hd, int qb) {
  const int tid_ = otid();
  const int lane = tid_ & 63, wid = tid_ >> 6, r = lane & 31, h = lane >> 5;
  const bf16_t* MQ = (const bf16_t*)(p.ws + OFF_MQ); const bf16_t* KV = (const bf16_t*)(p.ws + OFF_KV); bf16_t* MIX = (bf16_t*)(p.ws + OFF_MIX);
  const float* sc = (const float*)(p.ws + OFF_SCAL) + l * 16;
  const int seq0 = lat ? NCTX + b * 4096 : b * 256; const int row0 = seq0 + qb * 256;
  float lsum[1]; f32x16 acc[1][2];
  const bf16_t* K0 = KV + (size_t)seq0 * LKV + hd * 160; const bf16_t* K1 = KV + (size_t)(NTOK + b * 256) * LKV + hd * 160;
  const MlaQFix qf{(const float*)(p.ws + OFF_SSQ) + row0, p.mla_qk_gain + l * 192, (const float2*)(p.ws + OFF_ROPE32), lat ? 1 : 0, row0 - seq0, 0.10206207261596575f * LOG2E};
  attn_item<96, 1, false>(lds, MQ + (size_t)row0 * LMQ + hd * 96, LMQ, K0, K0 + 96, LKV, LKV, lat ? 32 : 2, K1, K1 + 96, LKV, LKV, lat ? 2 : 0, sc[3], lsum, acc, qf);
  const float inv = 1.0f / lsum[0]; bf16_t* op = MIX + (size_t)(row0 + wid * 32 + r) * D + 512 + hd * 64;
#pragma unroll
  for (int dvt = 0; dvt < 2; ++dvt)
#pragma unroll
    for (int g4 = 0; g4 < 4; ++g4) { u32x2 w; w.x = pk2(acc[0][dvt][4 * g4] * inv, acc[0][dvt][4 * g4 + 1] * inv); w.y = pk2(acc[0][dvt][4 * g4 + 2] * inv, acc[0][dvt][4 * g4 + 3] * inv);
      *(u32x2*)(op + dvt * 32 + 8 * g4 + 4 * h) = w; }
}

DI void diff_item(const Params& p, int l, LAS unsigned char* lds, bool lat, int b, int hd, int qb) {
  const int tid_ = otid();
  const int lane = tid_ & 63, wid = tid_ >> 6, r = lane & 31, h = lane >> 5;
  const bf16_t* QKV = (const bf16_t*)(p.ws + OFF_QKV); const bf16_t* DKC = (const bf16_t*)(p.ws + OFF_DKC); const bf16_t* DVC = (const bf16_t*)(p.ws + OFF_DVC); bf16_t* MIX = (bf16_t*)(p.ws + OFF_MIX);
  const float* sc = (const float*)(p.ws + OFF_SCAL) + l * 16;
  const int seq0 = lat ? NCTX + b * 4096 : b * 256; const int row0 = seq0 + qb * 256;
  float lsum[2]; f32x16 acc[2][2];
  const bf16_t* K0 = QKV + (size_t)seq0 * LQKV + 1280 + hd * 64; const bf16_t* V0 = QKV + (size_t)seq0 * LQKV + 1536 + hd * 64;
  const bf16_t* K1 = DKC + (size_t)(b * 256) * 256 + hd * 64; const bf16_t* V1 = DVC + (size_t)(b * 256) * 256 + hd * 64;
  attn_item<32, 2, true>(lds, QKV + (size_t)row0 * LQKV + 1024 + hd * 64, LQKV, K0, V0, LQKV, LQKV, lat ? 32 : 2, K1, V1, 256, 256, lat ? 2 : 0, sc[2], lsum, acc, DiffQFix{p.diff_qk_gain + l * 64, (const float2*)(p.ws + OFF_ROPE32), lat ? 1 : 0, row0 - seq0, 0.17677669529663687f * LOG2E});
  const float lam = sc[0], oml = 1.0f - sc[1]; const float i0 = 1.0f / lsum[0], i1 = lam / lsum[1];
  float ss = 0.f;
#pragma unroll
  for (int dvt = 0; dvt < 2; ++dvt)
#pragma unroll
    for (int i = 0; i < 16; ++i) { const float o = acc[0][dvt][i] * i0 - acc[1][dvt][i] * i1; acc[0][dvt][i] = o; ss += o * o; }
  ss += sx(ss, 32); const float rstd = rsqrtf(ss * (1.0f / 64.0f) + EPS) * oml;
  const float* sg = p.diff_subln + l * 64; bf16_t* op = MIX + (size_t)(row0 + wid * 32 + r) * D + 256 + hd * 64;
#pragma unroll
  for (int dvt = 0; dvt < 2; ++dvt)
#pragma unroll
    for (int g4 = 0; g4 < 4; ++g4) { const int dv = dvt * 32 + 8 * g4 + 4 * h; const f32x4 gg = *(const f32x4*)(sg + dv);
      u32x2 w; w.x = pk2(acc[0][dvt][4 * g4] * rstd * gg[0], acc[0][dvt][4 * g4 + 1] * rstd * gg[1]); w.y = pk2(acc[0][dvt][4 * g4 + 2] * rstd * gg[2], acc[0][dvt][4 * g4 + 3] * rstd * gg[3]);
      *(u32x2*)(op + dv) = w; }
}

DI void ret_item(const Params& p, int l, LAS unsigned char* lds, bool lat, int b, int hd, int qb) {
  const int tid_ = otid();
  const int tid = tid_, lane = tid & 63, wid = tid >> 6, r = lane & 31, h = lane >> 5, q4 = (lane & 15) >> 2, p4 = lane & 3, g = (lane >> 4) & 1;
  const bf16_t* QKV = (const bf16_t*)(p.ws + OFF_QKV); const float* U = (const float*)(p.ws + OFF_U); bf16_t* MIX = (bf16_t*)(p.ws + OFF_MIX);
  const float* sc = (const float*)(p.ws + OFF_SCAL) + l * 16; const float lgf = sc[4 + hd], lgb = sc[8 + hd];
  const int seq0 = lat ? NCTX + b * 4096 : b * 256; const int row0 = seq0 + qb * 256;
  constexpr int KOFF = 0, VOFF = 36864, SOFF = 73728, RS = 144;
#pragma unroll
  for (int i = 0; i < 4; ++i) { const int id = tid + i * 512, row = id >> 3, cc = id & 7; const bf16_t* src = QKV + (size_t)(row0 + row) * LQKV + hd * 64 + cc * 8;
    const u32x4 kv = *(const u32x4*)(src + 256), vv = *(const u32x4*)(src + 512);
    *(LAS u32x4*)(lds + KOFF + row * RS + cc * 16) = kv; *(LAS u32x4*)(lds + VOFF + row * RS + cc * 16) = vv; }
#pragma unroll
  for (int i = 0; i < 8; ++i) { const int id = tid + i * 512, mat = id >> 10, e4 = id & 1023, ci = mat >> 1, dir = mat & 1; const int ch = qb * 2 + ci;
    const size_t uidx = lat ? (size_t)(512 + ((b * 4 + hd) * 2 + dir) * 32 + ch) : (size_t)(((b * 4 + hd) * 2 + dir) * 2 + ch);
    const f32x4 v = *(const f32x4*)(U + uidx * 4096 + e4 * 4); const int dk = e4 >> 4, dv = (e4 & 15) * 4;
    u32x2 w; w.x = pk2(v[0], v[1]); w.y = pk2(v[2], v[3]); *(LAS u32x2*)(lds + SOFF + mat * 9216 + dk * RS + dv * 2) = w; }
  const int ci = wid >> 2, n = (wid & 3) * 32 + r; const int row = row0 + ci * 128 + n;
  bf16x8 qreg[4];
#pragma unroll
  for (int ks = 0; ks < 4; ++ks) qreg[ks] = *(const bf16x8*)(QKV + (size_t)row * LQKV + hd * 64 + ks * 16 + 8 * h);
  __syncthreads();
  f32x16 accO[2], accF[2], accB[2];
#pragma unroll
  for (int d = 0; d < 2; ++d)
#pragma unroll
    for (int i = 0; i < 16; ++i) { accO[d][i] = 0.f; accF[d][i] = 0.f; accB[d][i] = 0.f; }
#pragma unroll
  for (int kt = 0; kt < 4; ++kt) {
    f32x16 s; for (int i = 0; i < 16; ++i) s[i] = 0.f;
#pragma unroll
    for (int ks = 0; ks < 4; ++ks) { const bf16x8 kf = *(const LAS bf16x8*)(lds + KOFF + (ci * 128 + kt * 32 + r) * RS + (ks * 16 + 8 * h) * 2); s = MFMA32(kf, qreg[ks], s); }
#pragma unroll
    for (int i = 0; i < 16; ++i) { const int m = kt * 32 + crow(i, h); const int d = n - m; const float w = d > 0 ? fast_exp2((float)d * lgf) : (d < 0 ? fast_exp2((float)(-d) * lgb) : 2.0f); s[i] *= w; }
    u32x4 p0, p1; p0.x = pk2(s[0], s[1]); p0.y = pk2(s[2], s[3]); p0.z = pk2(s[4], s[5]); p0.w = pk2(s[6], s[7]);
    p1.x = pk2(s[8], s[9]); p1.y = pk2(s[10], s[11]); p1.z = pk2(s[12], s[13]); p1.w = pk2(s[14], s[15]);
    const bf16x8 pb0 = __builtin_bit_cast(bf16x8, p0), pb1 = __builtin_bit_cast(bf16x8, p1);
#pragma unroll
    for (int dvt = 0; dvt < 2; ++dvt) {
      LAS unsigned char* va = lds + VOFF + (ci * 128 + kt * 32 + 4 * h + q4) * RS + (dvt * 32 + 16 * g + 4 * p4) * 2;
      const bf16x8 v0 = cat8(tr_read(va), tr_read(va + 8 * RS)); const bf16x8 v1 = cat8(tr_read(va + 16 * RS), tr_read(va + 24 * RS));
      accO[dvt] = MFMA32(v0, pb0, accO[dvt]); accO[dvt] = MFMA32(v1, pb1, accO[dvt]); }
  }
#pragma unroll
  for (int ks = 0; ks < 4; ++ks)
#pragma unroll
    for (int dvt = 0; dvt < 2; ++dvt) {
      LAS unsigned char* sa = lds + SOFF + (ci * 2) * 9216 + (16 * ks + 8 * h + q4) * RS + (dvt * 32 + 16 * g + 4 * p4) * 2;
      const bf16x8 sf = cat8(tr_read(sa), tr_read(sa + 4 * RS)); const bf16x8 sb = cat8(tr_read(sa + 9216), tr_read(sa + 9216 + 4 * RS));
      accF[dvt] = MFMA32(sf, qreg[ks], accF[dvt]); accB[dvt] = MFMA32(sb, qreg[ks], accB[dvt]); }
  const float af = fast_exp2((float)(n + 1) * lgf), ab = fast_exp2((float)(128 - n) * lgb);
  float sum = 0.f;
#pragma unroll
  for (int dvt = 0; dvt < 2; ++dvt)
#pragma unroll
    for (int i = 0; i < 16; ++i) { const float o = accO[dvt][i] + af * accF[dvt][i] + ab * accB[dvt][i]; accO[dvt][i] = o; sum += o; }
  sum += sx(sum, 32); const float mu = sum * (1.0f / 64.0f); float var = 0.f;
#pragma unroll
  for (int dvt = 0; dvt < 2; ++dvt)
#pragma unroll
    for (int i = 0; i < 16; ++i) { const float dlt = accO[dvt][i] - mu; accO[dvt][i] = dlt; var += dlt * dlt; }
  var += sx(var, 32); const float rstd = rsqrtf(var * (1.0f / 64.0f) + EPS);
  const float* gn = p.ret_gn + l * 256 + hd * 64; const bf16_t* rg = QKV + (size_t)row * LQKV + 768 + hd * 64; bf16_t* op = MIX + (size_t)row * D + hd * 64;
#pragma unroll
  for (int dvt = 0; dvt < 2; ++dvt)
#pragma unroll
    for (int g4 = 0; g4 < 4; ++g4) { const int dv = dvt * 32 + 8 * g4 + 4 * h; const f32x4 gg = *(const f32x4*)(gn + dv); const u32x2 ga = *(const u32x2*)(rg + dv);
      const float gt[4] = {bflo(ga.x), bfhi(ga.x), bflo(ga.y), bfhi(ga.y)}; float y[4];
#pragma unroll
      for (int j = 0; j < 4; ++j) { const float sl = gt[j] * __builtin_amdgcn_rcpf(1.0f + __expf(-gt[j])); y[j] = accO[dvt][4 * g4 + j] * rstd * gg[j] * sl; }
      u32x2 w; w.x = pk2(y[0], y[1]); w.y = pk2(y[2], y[3]); *(u32x2*)(op + dv) = w; }
  __syncthreads();
}

DI void phase_mixers(const Params& p, int l, LAS unsigned char* lds) {
  unsigned* cnt = (unsigned*)(p.ws + OFF_CNT) + l * 8; LAS unsigned* slot = (LAS unsigned*)(lds + LDS_CTL);
  const int myx = (int)((unsigned)__builtin_amdgcn_s_getreg((3 << 11) | 20) & 7u);
  for (;;) {
    if (otid() == 0) {
      unsigned got = 0xffffffffu;
      for (int k = 0; k < 8; ++k) { const int y = (myx + k) & 7; const unsigned idx = atomicAdd(cnt + y, 1u); if (idx < 320u) { got = (unsigned)y * 320u + idx; break; } }
      *slot = got;
    }
    __syncthreads();
    const int enc = __builtin_amdgcn_readfirstlane((int)*slot);
    __syncthreads();
    if (enc < 0) break;
    const int x = enc / 320, j = enc % 320;
    if (j < 64) { const int gi = (j >> 4) * 8 + x, qb = j & 15; diff_item(p, l, lds, true, gi >> 2, gi & 3, qb); }
    else if (j < 192) { const int jj = j - 64, gi = (jj >> 4) * 8 + x, qb = jj & 15; mla_item(p, l, lds, true, gi >> 3, gi & 7, qb); }
    else if (j < 256) { const int jj = j - 192, gi = (jj >> 4) * 8 + x, qb = jj & 15; ret_item(p, l, lds, true, gi >> 2, gi & 3, qb); }
    else if (j < 288) { const int gi = (j - 256) * 8 + x; mla_item(p, l, lds, false, gi >> 3, gi & 7, 0); }
    else if (j < 304) { const int gi = (j - 288) * 8 + x; diff_item(p, l, lds, false, gi >> 2, gi & 3, 0); }
    else { const int gi = (j - 304) * 8 + x; ret_item(p, l, lds, false, gi >> 2, gi & 3, 0); }
  }
}


#define XB_TMO      128
#define XB_XCNT(j)  (256  + 64 * (j))
#define XB_XSUB(j)  (1280 + 64 * (j))
#define XB_XGEN(j)  (2304 + 64 * (j))
#define XB_TOP      3328
#define XB_TOPGEN   3392
#define XCD_BAR_WORDS 3456
#define XB_SPIN_CAP (1u << 20)
DI unsigned xb_ld(unsigned* p)              { return __hip_atomic_load(p, __ATOMIC_RELAXED, __HIP_MEMORY_SCOPE_AGENT); }
DI unsigned xb_add(unsigned* p, unsigned v) { return __hip_atomic_fetch_add(p, v, __ATOMIC_RELAXED, __HIP_MEMORY_SCOPE_AGENT); }
DI unsigned xb_xcc_id() { return (unsigned)__builtin_amdgcn_s_getreg((3 << 11) | 20) & 0xFu; }
#define XB_SPIN(cond, bar) do { unsigned _sp = 0; while (cond) { __builtin_amdgcn_s_sleep(1); \
    if ((++_sp & 255u) == 0u) { if (xb_ld(&(bar)[XB_TMO])) break; if (_sp > XB_SPIN_CAP) { atomicAdd(&(bar)[XB_TMO], 1u); break; } } } } while (0)
struct XcdBarrier { unsigned* bar; unsigned x; volatile LAS unsigned* st; };
DI XcdBarrier xcd_barrier_post(unsigned* bar, volatile LAS unsigned* st) {
  XcdBarrier b; b.bar = bar; b.x = xb_xcc_id(); b.st = st;
  if (threadIdx.x == 0) (void)xb_add(&bar[XB_XCNT(b.x)], 1u);
  return b;
}
DI void xcd_barrier_complete(unsigned* bar, unsigned x, unsigned& nloc, unsigned& nx) {
  const unsigned G = gridDim.x * gridDim.y * gridDim.z;
  unsigned sum, cnt, mine, sp = 0u;
  for (;;) {
    sum = 0u; cnt = 0u; mine = 0u;
#pragma unroll
    for (unsigned j = 0; j < 16; ++j) { const unsigned c = xb_ld(&bar[XB_XCNT(j)]); sum += c; cnt += (c > 0u) ? 1u : 0u; mine = (j == x) ? c : mine; }
    if (sum == G) break;
    __builtin_amdgcn_s_sleep(1);
    if ((++sp & 255u) == 0u) { if (xb_ld(&bar[XB_TMO])) break; if (sp > XB_SPIN_CAP) { atomicAdd(&bar[XB_TMO], 1u); break; } }
  }
  nloc = mine > 0u ? mine : 1u; nx = cnt > 0u ? cnt : 1u;
}
DI void xcd_barrier(const XcdBarrier& b) {
  asm volatile("s_waitcnt vmcnt(0)" ::: "memory");
  __syncthreads();
  if (threadIdx.x == 0) {
    unsigned* bar = b.bar;
    __builtin_amdgcn_s_waitcnt(0);
    unsigned nloc = b.st[0], nx = b.st[1];
    if (nloc == 0u) { xcd_barrier_complete(bar, b.x, nloc, nx); b.st[0] = nloc; b.st[1] = nx; }
    const unsigned old = xb_add(&bar[XB_XSUB(b.x)], 1u);
    const unsigned gen = old / nloc;
    if (old + 1u == (gen + 1u) * nloc) {
      __builtin_amdgcn_fence(__ATOMIC_RELEASE, "agent");
      asm volatile("s_waitcnt vmcnt(0)" ::: "memory");
      const unsigned og = xb_add(&bar[XB_TOP], 1u);
      const unsigned tg = og / nx;
      if (og + 1u == (tg + 1u) * nx) xb_add(&bar[XB_TOPGEN], 1u);
      else XB_SPIN(xb_ld(&bar[XB_TOPGEN]) == tg, bar);
      __builtin_amdgcn_fence(__ATOMIC_ACQUIRE, "agent");
      xb_add(&bar[XB_XGEN(b.x)], 1u);
      asm volatile("s_waitcnt vmcnt(0)" ::: "memory");
    } else {
      XB_SPIN(xb_ld(&bar[XB_XGEN(b.x)]) == gen, bar);
      __builtin_amdgcn_fence(__ATOMIC_ACQUIRE, "agent");
      asm volatile("s_waitcnt vmcnt(0)" ::: "memory");
    }
  }
  __syncthreads();
}

__global__ void __launch_bounds__(512, 2) fwd_megakernel(Params p) {
  extern __shared__ __attribute__((aligned(16))) unsigned char smem[];
  LAS unsigned char* lds = (LAS unsigned char*)smem;
  cg::grid_group grid = cg::this_grid();
  const int G = gridDim.x, c = blockIdx.x;
  unsigned char* ws = p.ws;
  volatile LAS unsigned* bst = (volatile LAS unsigned*)(lds + LDS_CTL + 16);
  if (threadIdx.x == 0) { bst[0] = 0u; bst[1] = 0u; }
  __syncthreads();
  XcdBarrier xbar; xbar.bar = (unsigned*)(ws + OFF_BAR); xbar.x = 0; xbar.st = bst;
  if (p.ph_hi - p.ph_lo > 1) xbar = xcd_barrier_post((unsigned*)(ws + OFF_BAR), bst);
  for (int ph = (int)p.ph_lo; ph < (int)p.ph_hi; ++ph) {
    if (ph == 0) phase0(p, lds);
    else {
      const int l = (ph - 1) / 10, s = (ph - 1) % 10;
      const float* modl = (const float*)(ws + OFF_MOD) + (size_t)l * 9 * 6144;
      pg8::StaticOrder S;
      if (s == 0) phase_norm(p, l, 0, lds);
      else if (s == 1) { pg8::Gemm g{(const bf16_t*)(ws + OFF_H), (const bf16_t*)(ws + OFF_WIN), NTOK, 3072, 1024, 1024}; S.init(g.M, g.N, G, c);
        EpiIn E{(bf16_t*)(ws + OFF_QKV), (bf16_t*)(ws + OFF_CQ), (bf16_t*)(ws + OFF_CKV), (bf16_t*)(ws + OFF_KR), (float*)(ws + OFF_SSQ)}; pg8::gemm_phase(lds, g, S, E); }
      else if (s == 2) phase_post1(p, l);
      else if (s == 3) {
        { pg8::Gemm g{(const bf16_t*)(ws + OFF_CQ), (const bf16_t*)(ws + OFF_WUQ), NTOK, 768, 768, 768}; S.init(g.M, g.N, G, c); EpiPlain E{(bf16_t*)(ws + OFF_MQ), LMQ}; pg8::gemm_phase(lds, g, S, E); }
        { pg8::Gemm g{(const bf16_t*)(ws + OFF_CKV), (const bf16_t*)(ws + OFF_WUKV), NKVROWS, 1024, 256, 256}; S.init(g.M, g.N, G, c); EpiKV E{(bf16_t*)(ws + OFF_KV)}; pg8::gemm_phase(lds, g, S, E); }
        __syncthreads();
        ret_u_items(p, l, lds);
      }
      else if (s == 4) phase_post2(p, l);
      else if (s == 5) phase_mixers(p, l, lds);
      else if (s == 6) { pg8::Gemm g{(const bf16_t*)(ws + OFF_MIX), (const bf16_t*)(ws + OFF_WOUT), NTOK, 1024, 1024, 1024}; S.init(g.M, g.N, G, c); EpiRes E{p.out, modl, 2048, l == 0 ? p.x_prompt : (const float*)nullptr, p.x_sample}; pg8::gemm_phase(lds, g, S, E); }
      else if (s == 7) phase_norm(p, l, 1, lds);
      else if (s == 8) { pg8::Gemm g{(const bf16_t*)(ws + OFF_H), (const bf16_t*)(ws + OFF_WGU), NTOK, 5632, 1024, 1024}; S.init(g.M, g.N, G, c); EpiGU E{(bf16_t*)(ws + OFF_ACT)}; pg8::gemm_phase(lds, g, S, E); }
      else { pg8::Gemm g{(const bf16_t*)(ws + OFF_ACT), (const bf16_t*)(ws + OFF_WDOWN), NTOK, 1024, 2816, 2816}; S.init(g.M, g.N, G, c); EpiRes E{p.out, modl, 5120, (const float*)nullptr, p.x_sample}; pg8::gemm_phase(lds, g, S, E); }
    }
    if (ph + 1 < (int)p.ph_hi) { if (p.ph_lo < 0) grid.sync(); xcd_barrier(xbar); }
  }
}

constexpr int NPHASES = 41;

extern "C" void kernel_launch(void* const* d_in, const int* in_sizes, int n_in, void* d_out, int out_size, void* d_ws, size_t ws_size, hipStream_t stream) {
  static int grid = 0;
  if (grid == 0) {
    if (n_in != 27 || ws_size < WS_END) { fprintf(stderr, "kernel_launch: unexpected n_in %d / ws_size %zu (need %zu)\n", n_in, ws_size, (size_t)WS_END); grid = -1; return; }
    int dev = 0, cus = 0, per_cu = 0;
    (void)hipGetDevice(&dev); (void)hipDeviceGetAttribute(&cus, hipDeviceAttributeMultiprocessorCount, dev);
    if (hipFuncSetAttribute((const void*)fwd_megakernel, hipFuncAttributeMaxDynamicSharedMemorySize, LDS_BYTES) != hipSuccess) { fprintf(stderr, "kernel_launch: hipFuncSetAttribute failed\n"); grid = -1; return; }
    if (hipOccupancyMaxActiveBlocksPerMultiprocessor(&per_cu, (const void*)fwd_megakernel, 512, LDS_BYTES) != hipSuccess || per_cu < 1) { fprintf(stderr, "kernel_launch: occupancy query gave %d\n", per_cu); per_cu = 1; }
    (void)hipGetLastError();
    grid = cus * 1;
  }
  if (grid < 0) return;
  (void)hipMemsetAsync((char*)d_ws + OFF_CNT, 0, 16384, stream);
  Params p{};
  const float** pp = (const float**)&p;
  for (int i = 0; i < 27; ++i) pp[i] = (const float*)d_in[i];
  p.out = (float*)d_out; p.ws = (unsigned char*)d_ws;
#if MK_COOP
  p.ph_lo = 0; p.ph_hi = NPHASES;
  void* args[] = {&p};
  hipError_t e = hipLaunchCooperativeKernel((const void*)fwd_megakernel, dim3(grid), dim3(512), args, LDS_BYTES, stream);
  if (e != hipSuccess) fprintf(stderr, "cooperative launch failed: %s (grid %d)\n", hipGetErrorString(e), grid);
#else
  for (int ph = 0; ph < NPHASES; ++ph) { p.ph_lo = ph; p.ph_hi = ph + 1; hipLaunchKernelGGL(fwd_megakernel, dim3(grid), dim3(512), LDS_BYTES, stream, p); }
#endif
}
```
